# Optimizing an MI355X kernel written in HIP

```python
import math
import jax
import jax.numpy as jnp
from jax import lax
import numpy as np

D_MODEL = 2048
BATCH = 8
SEQ = 2048
DEPTH = 2

CTX_LEN = 256
GRID_W = 64
HEAD_DIM = 128
Q_BLOCK = 128
ROPE_THETA = 10000.0
NORM_EPS = 1e-6
LN_EPS = 1e-5
MIX_HALF = D_MODEL // 2

CONV_CH = MIX_HALF
CONV_WIDTH = 31
GQA_Q_HEADS = MIX_HALF // HEAD_DIM
GQA_KV_HEADS = max(1, GQA_Q_HEADS // 4)
GQA_GROUP = GQA_Q_HEADS // GQA_KV_HEADS
GQA_Q = GQA_Q_HEADS * HEAD_DIM
GQA_KV = GQA_KV_HEADS * HEAD_DIM
IN_EVEN = 2 * CONV_CH + GQA_Q + 2 * GQA_KV
MIX_EVEN = CONV_CH + GQA_Q

HYENA_CH = MIX_HALF
HYENA_ORDER = 2
HYENA_SHORT = 3
HYENA_POS_DIM = 33
HYENA_FILTER_WIDTH = 64
HYENA_FAST_DECAY = 0.3
HYENA_SLOW_DECAY = 1.5
HYENA_TARGET = 1e-2
HYENA_MAX_DECAY = math.log(HYENA_TARGET) / HYENA_FAST_DECAY
HYENA_MIN_DECAY = math.log(HYENA_TARGET) / HYENA_SLOW_DECAY
HYENA_IN = (HYENA_ORDER + 1) * HYENA_CH
MLA_HEADS = MIX_HALF // HEAD_DIM
MLA_Q_RANK = D_MODEL // 4
MLA_KV_RANK = D_MODEL // 8
MLA_NOPE = HEAD_DIM
MLA_ROPE = HEAD_DIM // 2
MLA_V = HEAD_DIM
MLA_QK = MLA_NOPE + MLA_ROPE
IN_ODD = HYENA_IN + MLA_Q_RANK + MLA_KV_RANK + MLA_ROPE
MIX_ODD = HYENA_CH + MLA_HEADS * MLA_V

FFN_RAW = -(-8 * D_MODEL // 3)
FFN_HIDDEN = -(-FFN_RAW // 256) * 256

kernel_name = 'hybrid_diffusion_conv_gqa_hyena_mla'


def rms_norm(x, g, eps=NORM_EPS):
    xf = x.astype(jnp.float32)
    y = xf * lax.rsqrt(jnp.mean(xf * xf, axis=-1, keepdims=True) + eps)
    return (y * g.astype(jnp.float32)).astype(x.dtype)


def layer_norm(x, g, b, eps=LN_EPS):
    xf = x.astype(jnp.float32)
    mu = jnp.mean(xf, axis=-1, keepdims=True)
    xc = xf - mu
    var = jnp.mean(xc * xc, axis=-1, keepdims=True)
    y = xc * lax.rsqrt(var + eps) * g.astype(jnp.float32) + b.astype(jnp.float32)
    return y.astype(x.dtype)


def modulate(h, shift, scale):
    return h * (1 + scale) + shift


def rope_1d(x, pos):
    d = x.shape[-1]
    half = d // 2
    inv = ROPE_THETA ** (-jnp.arange(half, dtype=jnp.float32) / half)
    ang = pos[:, None] * inv[None, :]
    shape = (pos.shape[0],) + (1,) * (x.ndim - 3) + (half,)
    cos = jnp.cos(ang).reshape(shape)
    sin = jnp.sin(ang).reshape(shape)
    xf = x.astype(jnp.float32)
    x1, x2 = xf[..., :half], xf[..., half:]
    return jnp.concatenate([x1 * cos - x2 * sin, x1 * sin + x2 * cos], axis=-1).astype(x.dtype)


def axial_rope(x, row, col):
    h = x.shape[-1] // 2
    return jnp.concatenate([rope_1d(x[..., :h], row), rope_1d(x[..., h:], col)], axis=-1)


def blocked_attention(q, k, v, scale):
    B, L, Hk, G, dk = q.shape
    nb = L // Q_BLOCK
    qb = jnp.moveaxis(q.reshape(B, nb, Q_BLOCK, Hk, G, dk), 1, 0)

    def one_block(qi):
        s = jnp.einsum('bqhgd,bthd->bhgqt', qi, k, preferred_element_type=jnp.float32) * scale
        p = jax.nn.softmax(s, axis=-1).astype(v.dtype)
        return jnp.einsum('bhgqt,bthd->bqhgd', p, v)

    out = lax.map(one_block, qb)
    return jnp.moveaxis(out, 0, 1).reshape(B, L, Hk, G, v.shape[-1])


def depthwise_conv(x, w, b):
    K, C = w.shape
    pad = (K - 1) // 2
    y = lax.conv_general_dilated(x, w.astype(x.dtype)[:, None, :], window_strides=(1,),
                                 padding=[(pad, pad)], dimension_numbers=('NWC', 'WIO', 'NWC'),
                                 feature_group_count=C)
    return y + b.astype(x.dtype)


def swiglu(h, wg, wu, wd):
    return (jax.nn.silu(h @ wg) * (h @ wu)) @ wd


def conformer_conv(z, dw_w, dw_b, ln_g, ln_b):
    a, g = jnp.split(z, 2, axis=-1)
    u = a * jax.nn.sigmoid(g)
    u = depthwise_conv(u, dw_w, dw_b)
    return jax.nn.silu(layer_norm(u, ln_g, ln_b))


def gqa_q(zq, qn_g):
    B, L = zq.shape[:2]
    return rms_norm(zq.reshape(B, L, GQA_KV_HEADS, GQA_GROUP, HEAD_DIM), qn_g)


def gqa_kv(zkv, kn_g):
    B, L = zkv.shape[:2]
    k = rms_norm(zkv[..., :GQA_KV].reshape(B, L, GQA_KV_HEADS, HEAD_DIM), kn_g)
    v = zkv[..., GQA_KV:].reshape(B, L, GQA_KV_HEADS, HEAD_DIM)
    return k, v


def even_mixer(h, hc, w_in, w_out, dw_w, dw_b, ln_g, ln_b, qn_g, kn_g, row, col, ctx_out):
    B, L, _ = h.shape
    Lc = hc.shape[1]
    q0 = 2 * CONV_CH
    kv0 = q0 + GQA_Q
    scale = HEAD_DIM ** -0.5
    z = h @ w_in
    q = axial_rope(gqa_q(z[..., q0:kv0], qn_g), row, col)
    k, v = gqa_kv(z[..., kv0:], kn_g)
    k = axial_rope(k, row, col)
    kc, vc = gqa_kv(hc @ w_in[:, kv0:], kn_g)
    att = blocked_attention(q, jnp.concatenate([kc, k], axis=1), jnp.concatenate([vc, v], axis=1), scale)
    conv = conformer_conv(z[..., :q0], dw_w, dw_b, ln_g, ln_b)
    out = jnp.concatenate([conv, att.reshape(B, L, GQA_Q)], axis=-1) @ w_out
    if not ctx_out:
        return out, None
    zc = hc @ w_in[:, :kv0]
    att_c = blocked_attention(gqa_q(zc[..., q0:], qn_g), kc, vc, scale)
    conv_c = conformer_conv(zc[..., :q0], dw_w, dw_b, ln_g, ln_b)
    out_c = jnp.concatenate([conv_c, att_c.reshape(B, Lc, GQA_Q)], axis=-1) @ w_out
    return out, out_c


def hyena_filters(L, w1, b1, w2, b2, w3, b3, w4, freq):
    f32 = jnp.float32
    t = jnp.linspace(0.0, 1.0, L, dtype=f32)[:, None]
    bands = (HYENA_POS_DIM - 1) // 2
    w = (2.0 * math.pi / L) * jnp.arange(L, dtype=f32)[:, None]
    f = jnp.linspace(1e-4, bands - 1, bands, dtype=f32)[None, :]
    feat = jnp.concatenate([t, jnp.cos(f * w), -jnp.sin(f * w)], axis=-1)
    fr = freq.astype(f32)
    hh = jnp.sin(fr[0] * (feat @ w1.astype(f32) + b1.astype(f32)))
    hh = jnp.sin(fr[1] * (hh @ w2.astype(f32) + b2.astype(f32)))
    hh = jnp.sin(fr[2] * (hh @ w3.astype(f32) + b3.astype(f32)))
    hh = (hh @ w4.astype(f32)).reshape(L, 2, HYENA_ORDER, HYENA_CH)
    deltas = jnp.abs(jnp.linspace(HYENA_MIN_DECAY, HYENA_MAX_DECAY, HYENA_CH, dtype=f32))
    hh = hh * jnp.exp(-t * deltas[None, :])[:, None, None, :]
    return hh / (jnp.sum(jnp.abs(hh), axis=0, keepdims=True) + 1e-6)


def bidir_long_conv(u, h_fwd, h_bwd, skip):
    L, C = h_fwd.shape
    k = jnp.concatenate([h_fwd, jnp.zeros((1, C), h_fwd.dtype), h_bwd[:0:-1]], axis=0)
    kf = jnp.fft.rfft(k, axis=0)
    uf32 = u.astype(jnp.float32)
    uf = jnp.fft.rfft(uf32, n=2 * L, axis=1)
    y = jnp.fft.irfft(uf * kf[None], n=2 * L, axis=1)[:, :L]
    return (y + uf32 * skip.astype(jnp.float32)).astype(u.dtype)


def hyena_mix(z, short_w, short_b, filt, skip):
    L = z.shape[1]
    z = depthwise_conv(z, short_w, short_b)
    parts = jnp.split(z, HYENA_ORDER + 1, axis=-1)
    hh = hyena_filters(L, *filt)
    y = parts[-1]
    for n in range(HYENA_ORDER):
        y = parts[n] * bidir_long_conv(y, hh[:, 0, n], hh[:, 1, n], skip[n])
    return y


def mla_q(zq, qn_g, w_uq, row, col):
    B, L = zq.shape[:2]
    q = (rms_norm(zq, qn_g) @ w_uq).reshape(B, L, MLA_HEADS, MLA_QK)
    q_nope, q_rope = q[..., :MLA_NOPE], q[..., MLA_NOPE:]
    if row is not None:
        q_rope = axial_rope(q_rope, row, col)
    return jnp.concatenate([q_nope, q_rope], axis=-1)[:, :, :, None, :]


def mla_kv(zkv, kvn_g, w_ukv, row, col):
    B, L = zkv.shape[:2]
    ckv = rms_norm(zkv[..., :MLA_KV_RANK], kvn_g)
    k_rope = zkv[..., MLA_KV_RANK:]
    if row is not None:
        k_rope = axial_rope(k_rope, row, col)
    kv = (ckv @ w_ukv).reshape(B, L, MLA_HEADS, MLA_NOPE + MLA_V)
    k_nope, v = kv[..., :MLA_NOPE], kv[..., MLA_NOPE:]
    k = jnp.concatenate([k_nope, jnp.broadcast_to(k_rope[:, :, None, :], (B, L, MLA_HEADS, MLA_ROPE))], axis=-1)
    return k, v


def odd_mixer(h, hc, w_in, w_out, short_w, short_b, filt, skip, qn_g, kvn_g, w_uq, w_ukv, row, col, ctx_out):
    B, L, _ = h.shape
    Lc = hc.shape[1]
    kv0 = HYENA_IN + MLA_Q_RANK
    scale = MLA_QK ** -0.5
    z = h @ w_in
    y_h = hyena_mix(z[..., :HYENA_IN], short_w, short_b, filt, skip)
    q = mla_q(z[..., HYENA_IN:kv0], qn_g, w_uq, row, col)
    k, v = mla_kv(z[..., kv0:], kvn_g, w_ukv, row, col)
    kc, vc = mla_kv(hc @ w_in[:, kv0:], kvn_g, w_ukv, None, None)
    att = blocked_attention(q, jnp.concatenate([kc, k], axis=1), jnp.concatenate([vc, v], axis=1), scale)
    out = jnp.concatenate([y_h, att.reshape(B, L, MLA_HEADS * MLA_V)], axis=-1) @ w_out
    if not ctx_out:
        return out, None
    zc = hc @ w_in[:, :kv0]
    y_hc = hyena_mix(zc[..., :HYENA_IN], short_w, short_b, filt, skip)
    att_c = blocked_attention(mla_q(zc[..., HYENA_IN:], qn_g, w_uq, None, None), kc, vc, scale)
    out_c = jnp.concatenate([y_hc, att_c.reshape(B, Lc, MLA_HEADS * MLA_V)], axis=-1) @ w_out
    return out, out_c


def setup_inputs(seed: int = 0) -> dict:
    key = jax.random.key(seed)
    ks = iter(jax.random.split(key, 64))
    D = D_MODEL
    n_even = (DEPTH + 1) // 2
    n_odd = DEPTH // 2
    F = HYENA_FILTER_WIDTH

    def nrm(shape, scale):
        return scale * jax.random.normal(next(ks), shape, jnp.float32)

    def gain(shape):
        return 1.0 + nrm(shape, 0.01)

    return {
        'x': nrm((BATCH, SEQ, D), 1.0),
        'c': nrm((BATCH, D), 1.0),
        'ctx': nrm((BATCH, CTX_LEN, D), 1.0),
        'c_ctx': nrm((D,), 1.0),
        'ada_w': nrm((DEPTH, D, 6 * D), D ** -0.5),
        'ada_b': nrm((DEPTH, 6 * D), 0.01),
        'norm_mix_g': gain((DEPTH, D)),
        'norm_ffn_g': gain((DEPTH, D)),
        'e_w_in': nrm((n_even, D, IN_EVEN), D ** -0.5),
        'e_w_out': nrm((n_even, MIX_EVEN, D), MIX_EVEN ** -0.5),
        'e_dw_w': nrm((n_even, CONV_WIDTH, CONV_CH), CONV_WIDTH ** -0.5),
        'e_dw_b': nrm((n_even, CONV_CH), 0.01),
        'e_ln_g': gain((n_even, CONV_CH)),
        'e_ln_b': nrm((n_even, CONV_CH), 0.01),
        'e_qn_g': gain((n_even, HEAD_DIM)),
        'e_kn_g': gain((n_even, HEAD_DIM)),
        'o_w_in': nrm((n_odd, D, IN_ODD), D ** -0.5),
        'o_w_out': nrm((n_odd, MIX_ODD, D), MIX_ODD ** -0.5),
        'o_short_w': nrm((n_odd, HYENA_SHORT, HYENA_IN), HYENA_SHORT ** -0.5),
        'o_short_b': nrm((n_odd, HYENA_IN), 0.01),
        'o_f_w1': nrm((n_odd, HYENA_POS_DIM, F), HYENA_POS_DIM ** -0.5),
        'o_f_b1': nrm((n_odd, F), 0.01),
        'o_f_w2': nrm((n_odd, F, F), F ** -0.5),
        'o_f_b2': nrm((n_odd, F), 0.01),
        'o_f_w3': nrm((n_odd, F, F), F ** -0.5),
        'o_f_b3': nrm((n_odd, F), 0.01),
        'o_f_w4': nrm((n_odd, F, 2 * HYENA_ORDER * HYENA_CH), F ** -0.5),
        'o_f_freq': gain((n_odd, 3, F)),
        'o_skip': nrm((n_odd, HYENA_ORDER, HYENA_CH), 0.5),
        'o_q_norm_g': gain((n_odd, MLA_Q_RANK)),
        'o_kv_norm_g': gain((n_odd, MLA_KV_RANK)),
        'o_w_uq': nrm((n_odd, MLA_Q_RANK, MLA_HEADS * MLA_QK), MLA_Q_RANK ** -0.5),
        'o_w_ukv': nrm((n_odd, MLA_KV_RANK, MLA_HEADS * (MLA_NOPE + MLA_V)), MLA_KV_RANK ** -0.5),
        'ffn_w_gate': nrm((DEPTH, D, FFN_HIDDEN), D ** -0.5),
        'ffn_w_up': nrm((DEPTH, D, FFN_HIDDEN), D ** -0.5),
        'ffn_w_down': nrm((DEPTH, FFN_HIDDEN, D), FFN_HIDDEN ** -0.5),
        'final_norm_g': gain((D,)),
    }


def reference(x, c, ctx, c_ctx, ada_w, ada_b, norm_mix_g, norm_ffn_g,
              e_w_in, e_w_out, e_dw_w, e_dw_b, e_ln_g, e_ln_b, e_qn_g, e_kn_g,
              o_w_in, o_w_out, o_short_w, o_short_b, o_f_w1, o_f_b1, o_f_w2, o_f_b2,
              o_f_w3, o_f_b3, o_f_w4, o_f_freq, o_skip, o_q_norm_g, o_kv_norm_g, o_w_uq, o_w_ukv,
              ffn_w_gate, ffn_w_up, ffn_w_down, final_norm_g):
    S = x.shape[1]
    ROWS = S // GRID_W
    row = jnp.repeat(jnp.arange(ROWS, dtype=jnp.float32), GRID_W)
    col = jnp.tile(jnp.arange(GRID_W, dtype=jnp.float32), ROWS)
    cond = jax.nn.silu(c)
    cond_ctx = jax.nn.silu(c_ctx)
    for i in range(DEPTH):
        ctx_out = i < DEPTH - 1
        mod = cond @ ada_w[i] + ada_b[i]
        mod_c = cond_ctx @ ada_w[i] + ada_b[i]
        sm, scm, gm, sf, scf, gf = jnp.split(mod[:, None, :], 6, axis=-1)
        csm, cscm, cgm, csf, cscf, cgf = jnp.split(mod_c[None, None, :], 6, axis=-1)
        h = modulate(rms_norm(x, norm_mix_g[i]), sm, scm)
        hc = modulate(rms_norm(ctx, norm_mix_g[i]), csm, cscm)
        j = i // 2
        if i % 2 == 0:
            o, oc = even_mixer(h, hc, e_w_in[j], e_w_out[j], e_dw_w[j], e_dw_b[j], e_ln_g[j], e_ln_b[j],
                               e_qn_g[j], e_kn_g[j], row, col, ctx_out)
        else:
            filt = (o_f_w1[j], o_f_b1[j], o_f_w2[j], o_f_b2[j], o_f_w3[j], o_f_b3[j], o_f_w4[j], o_f_freq[j])
            o, oc = odd_mixer(h, hc, o_w_in[j], o_w_out[j], o_short_w[j], o_short_b[j], filt, o_skip[j],
                              o_q_norm_g[j], o_kv_norm_g[j], o_w_uq[j], o_w_ukv[j], row, col, ctx_out)
        x = x + gm * o
        x = x + gf * swiglu(modulate(rms_norm(x, norm_ffn_g[i]), sf, scf), ffn_w_gate[i], ffn_w_up[i], ffn_w_down[i])
        if ctx_out:
            ctx = ctx + cgm * oc
            ctx = ctx + cgf * swiglu(modulate(rms_norm(ctx, norm_ffn_g[i]), csf, cscf),
                                     ffn_w_gate[i], ffn_w_up[i], ffn_w_down[i])
    return rms_norm(x, final_norm_g)
```

```cpp
#include <hip/hip_runtime.h>
#include <hip/hip_cooperative_groups.h>
#include <cstdio>
#include <cstdint>
#include <cmath>
namespace cg = cooperative_groups;
#define DUPMASK 0u
#define SYNCDUP 0
namespace pg8 {
#define PG8_LAS __attribute__((address_space(3)))
typedef unsigned short bf16_t;
typedef short bf16x8 __attribute__((ext_vector_type(8)));
typedef float f32x4 __attribute__((ext_vector_type(4)));
typedef unsigned u32x4 __attribute__((ext_vector_type(4)));
constexpr int BM = 256, BK = 64, HALF = 128, HTB = HALF * BK * 2  , STAGE_BYTES = 8 * HTB, NXCD = 8, WGM = 4;

__host__ __device__ __forceinline__ int lds_byte(int r, int c) { const int st = (r >> 4) * 2 + (c >> 5), rr = r & 15, cc = c & 31, ob = rr * 64 + cc * 2; return st * 1024 + (ob ^ (((ob >> 9) & 1) << 5)); }
__host__ __device__ __forceinline__ void stage_rc(int b, int& R, int& C) { const int st = b / 1024, sb = b % 1024, swz = sb ^ (((sb >> 9) & 1) << 5); R = (st >> 1) * 16 + swz / 64; C = (st & 1) * 32 + (swz % 64) / 2; }
__host__ __device__ __forceinline__ int perm32(int rho) { const int n = rho >> 4, i = rho & 15; return 8 * (i >> 2) + 4 * n + (i & 3); }

struct Unit { int pm, pn; };
struct Gemm { const bf16_t* A; const bf16_t* Bt; int M, N, K; };

struct StaticOrder {
    int nM, nN, nwg, G, c;
    __host__ __device__ void init(int M, int N, int G_, int c_) { nM = M / BM; nN = N / BM; nwg = nM * nN; G = G_; c = c_; }
    __host__ __device__ bool next(int i, Unit& u) const {
        const long L = (long)i * G + c; if (L >= nwg) return false;
        int wgid = (int)L; { const int q = nwg / NXCD, r = nwg % NXCD, xcd = wgid % NXCD, off = wgid / NXCD; wgid = (xcd < r ? xcd * (q + 1) : r * (q + 1) + (xcd - r) * q) + off; }
        const int nig = WGM * nN, gid = wgid / nig, fm = gid * WGM, gsz = (nM - fm) < WGM ? (nM - fm) : WGM;
        u.pm = fm + ((wgid % nig) % gsz); u.pn = (wgid % nig) / gsz; return true;
    }
    __device__ __forceinline__ void a_ready(const Unit&) const {}
    __device__ __forceinline__ void done(const Unit&) const {}
};

__device__ __forceinline__ unsigned cvt_pk_bf16(float lo, float hi) { unsigned r; asm volatile("v_cvt_pk_bf16_f32 %0, %1, %2" : "=v"(r) : "v"(lo), "v"(hi)); return r; }
template <class Epi, class Sched, bool ALIGN_EPI = false, bool SP2 = false>
__device__ __forceinline__ void gemm_phase(PG8_LAS unsigned char* lds, const Gemm g, const Sched& S, const Epi& E) {
    const int tid = threadIdx.x, wid = __builtin_amdgcn_readfirstlane(tid >> 6), lane = tid & 63, wr = wid >> 2, wc = wid & 3, fr = lane & 15, fq = lane >> 4;
    const int K = g.K, nt = K / BK;
    unsigned voffA[2], voffB[2];
#pragma unroll
    for (int i = 0; i < 2; ++i) { int R, C; stage_rc(tid * 16 + i * 8192, R, C); const int Rb = Epi::PERM ? ((R & ~31) + perm32(R & 31)) : R;
        voffA[i] = (unsigned)(R * K + C) * 2u; voffB[i] = (unsigned)(Rb * K + C) * 2u; }
    const size_t kstep = (size_t)(BK * 2);
    const size_t hstep = (size_t)HALF * K * 2;
    const size_t tstep = 2 * hstep;
    const unsigned ldsw = (unsigned)wid * 1024u;
    const int aoff = lds_byte(wr * 64 + fr, fq * 8), boff = lds_byte(wc * 32 + fr, fq * 8);
#define PG8_SA(b, h) (((b) * 2 + (h)) * HTB)
#define PG8_SB(b, h) ((4 + (b) * 2 + (h)) * HTB)
#define PG8_STAGE(bufoff, gbase, voff) do { _Pragma("unroll") for (int _i = 0; _i < 2; ++_i) \
        __builtin_amdgcn_global_load_lds((const unsigned*)((const char*)(gbase) + (voff)[_i]), (PG8_LAS unsigned*)(lds + (bufoff) + ldsw + _i * 8192), 16, 0, 0); } while (0)
#define PG8_LDA(dst, b, h) do { _Pragma("unroll") for (int m = 0; m < 4; ++m) _Pragma("unroll") for (int k = 0; k < 2; ++k) dst[m][k] = *(const PG8_LAS bf16x8*)(lds + PG8_SA(b, h) + aoff + m * 2048 + k * 1024); } while (0)
#define PG8_LDB(dst, b, h) do { _Pragma("unroll") for (int n = 0; n < 2; ++n) _Pragma("unroll") for (int k = 0; k < 2; ++k) dst[n][k] = *(const PG8_LAS bf16x8*)(lds + PG8_SB(b, h) + boff + n * 2048 + k * 1024); } while (0)
#define PG8_MMA(ai, bj, At, Bt) do { __builtin_amdgcn_s_setprio(1); _Pragma("unroll") for (int m = 0; m < 4; ++m) _Pragma("unroll") for (int n = 0; n < 2; ++n) _Pragma("unroll") for (int k = 0; k < 2; ++k) \
        acc[ai][bj][m][n] = __builtin_amdgcn_mfma_f32_16x16x32_bf16(Bt[n][k], At[m][k], acc[ai][bj][m][n], 0, 0, 0); __builtin_amdgcn_s_setprio(0); } while (0)
#define PG8_WAIT_V(n) asm volatile("s_waitcnt vmcnt(" #n ")" ::: "memory")
#define PG8_WAIT_L(n) asm volatile("s_waitcnt lgkmcnt(" #n ")" ::: "memory")
#define PG8_BAR __builtin_amdgcn_s_barrier()
#define PG8_SCHED __builtin_amdgcn_sched_barrier(0)
    Unit cur, nxt; int ui = 0;
    if (!S.next(0, cur)) return;
    f32x4 acc[2][2][4][2];
#pragma unroll
    for (int a = 0; a < 2; ++a)
#pragma unroll
        for (int b = 0; b < 2; ++b)
#pragma unroll
            for (int m = 0; m < 4; ++m)
#pragma unroll
                for (int n = 0; n < 2; ++n) acc[a][b][m][n] = (f32x4){0.f, 0.f, 0.f, 0.f};
    bf16x8 At[4][2], B0[2][2], B1[2][2];
    const char* cA = (const char*)g.A + (size_t)cur.pm * tstep; const char* cB = (const char*)g.Bt + (size_t)cur.pn * tstep;
    S.a_ready(cur);
    if constexpr (SP2) {
        PG8_STAGE(PG8_SB(0, 0), cB, voffB); PG8_STAGE(PG8_SB(0, 1), cB + hstep, voffB); PG8_STAGE(PG8_SA(0, 0), cA, voffA); PG8_STAGE(PG8_SA(0, 1), cA + hstep, voffA);
        if (wr == 1) PG8_BAR;
        PG8_WAIT_V(2); PG8_BAR;
        PG8_STAGE(PG8_SB(1, 0), cB + kstep, voffB); PG8_STAGE(PG8_SA(1, 0), cA + kstep, voffA); PG8_STAGE(PG8_SB(1, 1), cB + hstep + kstep, voffB);
        PG8_WAIT_V(6); PG8_BAR;
    } else {
        PG8_STAGE(PG8_SB(0, 0), cB, voffB); PG8_STAGE(PG8_SA(0, 0), cA, voffA); PG8_STAGE(PG8_SB(0, 1), cB + hstep, voffB); PG8_STAGE(PG8_SA(0, 1), cA + hstep, voffA);
        if (wr == 1) PG8_BAR;
        PG8_WAIT_V(4); PG8_BAR;
        PG8_STAGE(PG8_SB(1, 0), cB + kstep, voffB); PG8_STAGE(PG8_SA(1, 0), cA + kstep, voffA); PG8_STAGE(PG8_SB(1, 1), cB + hstep + kstep, voffB);
        PG8_WAIT_V(6); PG8_BAR;
    }
    for (;;) {
        const bool has_next = S.next(ui + 1, nxt);
        const char* nA = has_next ? (const char*)g.A + (size_t)nxt.pm * tstep : cA; const char* nB = has_next ? (const char*)g.Bt + (size_t)nxt.pn * tstep : cB;
        for (int t = 0; t < nt; t += 2) {
            const bool last = (t == nt - 2);
            const char* a1 = cA + (size_t)(t + 1) * kstep;
            const char* a2 = last ? nA : cA + (size_t)(t + 2) * kstep; const char* b2 = last ? nB : cB + (size_t)(t + 2) * kstep;
            const char* a3 = a2 + kstep; const char* b3 = b2 + kstep;
            if (last && has_next) S.a_ready(nxt);
            if constexpr (SP2) {
            PG8_LDB(B0, 0, 0); PG8_LDB(B1, 0, 1); PG8_SCHED; PG8_LDA(At, 0, 0); PG8_STAGE(PG8_SA(1, 1), a1 + hstep, voffA);
            PG8_WAIT_V(8); PG8_WAIT_L(0); PG8_BAR; PG8_MMA(0, 0, At, B0); PG8_MMA(0, 1, At, B1); PG8_BAR; PG8_SCHED;
            PG8_LDA(At, 0, 1); PG8_STAGE(PG8_SB(0, 0), b2, voffB); PG8_STAGE(PG8_SB(0, 1), b2 + hstep, voffB); PG8_STAGE(PG8_SA(0, 0), a2, voffA);
            PG8_WAIT_V(8); PG8_WAIT_L(0); PG8_BAR; PG8_MMA(1, 0, At, B0); PG8_MMA(1, 1, At, B1); PG8_BAR; PG8_SCHED;
            PG8_LDB(B0, 1, 0); PG8_LDB(B1, 1, 1); PG8_SCHED; PG8_LDA(At, 1, 0); PG8_STAGE(PG8_SA(0, 1), a2 + hstep, voffA);
            PG8_WAIT_V(8); PG8_WAIT_L(0); PG8_BAR; PG8_MMA(0, 0, At, B0); PG8_MMA(0, 1, At, B1); PG8_BAR; PG8_SCHED;
            PG8_LDA(At, 1, 1); PG8_STAGE(PG8_SB(1, 0), b3, voffB); PG8_STAGE(PG8_SB(1, 1), b3 + hstep, voffB); PG8_STAGE(PG8_SA(1, 0), a3, voffA);
            PG8_WAIT_V(8); PG8_WAIT_L(0); PG8_BAR; PG8_MMA(1, 0, At, B0); PG8_MMA(1, 1, At, B1); PG8_BAR; PG8_SCHED;
            } else {
            PG8_LDB(B0, 0, 0); PG8_SCHED; PG8_LDA(At, 0, 0); PG8_STAGE(PG8_SA(1, 1), a1 + hstep, voffA);
            PG8_WAIT_L(8); PG8_BAR; PG8_WAIT_L(0); PG8_MMA(0, 0, At, B0); PG8_BAR; PG8_SCHED;
            PG8_LDB(B1, 0, 1); PG8_STAGE(PG8_SB(0, 0), b2, voffB);
            PG8_BAR; PG8_WAIT_L(0); PG8_MMA(0, 1, At, B1); PG8_BAR;
            PG8_LDA(At, 0, 1); PG8_STAGE(PG8_SA(0, 0), a2, voffA);
            PG8_BAR; PG8_WAIT_L(0); PG8_MMA(1, 0, At, B0); PG8_BAR; PG8_SCHED;
            PG8_STAGE(PG8_SB(0, 1), b2 + hstep, voffB);
            PG8_WAIT_V(6); PG8_BAR; PG8_MMA(1, 1, At, B1); PG8_BAR;
            PG8_LDB(B0, 1, 0); PG8_SCHED; PG8_LDA(At, 1, 0); PG8_STAGE(PG8_SA(0, 1), a2 + hstep, voffA);
            PG8_WAIT_L(8); PG8_BAR; PG8_WAIT_L(0); PG8_MMA(0, 0, At, B0); PG8_BAR; PG8_SCHED;
            PG8_LDB(B1, 1, 1); PG8_STAGE(PG8_SB(1, 0), b3, voffB);
            PG8_BAR; PG8_WAIT_L(0); PG8_MMA(0, 1, At, B1); PG8_BAR;
            PG8_LDA(At, 1, 1); PG8_STAGE(PG8_SA(1, 0), a3, voffA);
            PG8_BAR; PG8_WAIT_L(0); PG8_MMA(1, 0, At, B0); PG8_BAR; PG8_SCHED;
            PG8_STAGE(PG8_SB(1, 1), b3 + hstep, voffB);
            PG8_WAIT_V(6); PG8_BAR; PG8_MMA(1, 1, At, B1); PG8_BAR;
            }
        }
        if constexpr (ALIGN_EPI) { if (wr == 0) PG8_BAR; }
        if constexpr (!Epi::AFTER_DRAIN) { E(acc, cur, wr, wc, fr, fq); S.done(cur); }
        if (!has_next) break;
#pragma unroll
        for (int a = 0; a < 2; ++a)
#pragma unroll
            for (int b = 0; b < 2; ++b)
#pragma unroll
                for (int m = 0; m < 4; ++m)
#pragma unroll
                    for (int n = 0; n < 2; ++n) acc[a][b][m][n] = (f32x4){0.f, 0.f, 0.f, 0.f};
        cur = nxt; cA = nA; cB = nB; ++ui;
        if constexpr (ALIGN_EPI) { if (wr == 1) PG8_BAR; }
    }
    PG8_WAIT_V(0);
    if constexpr (!ALIGN_EPI) { if (wr == 0) PG8_BAR; }
    PG8_BAR;
    if constexpr (Epi::AFTER_DRAIN) { E.fused(acc, cur, wr, wc, fr, fq, lds, wid, lane); S.done(cur); }
#undef PG8_SA
#undef PG8_SB
#undef PG8_STAGE
#undef PG8_LDA
#undef PG8_LDB
#undef PG8_MMA
#undef PG8_WAIT_V
#undef PG8_WAIT_L
#undef PG8_BAR
#undef PG8_SCHED
}
}

namespace mk {
#define LAS __attribute__((address_space(3)))
typedef unsigned short bf16_t;
typedef float f32x4 __attribute__((ext_vector_type(4)));
typedef float f32x2 __attribute__((ext_vector_type(2)));
typedef float f32x16 __attribute__((ext_vector_type(16)));
typedef short bf16x8 __attribute__((ext_vector_type(8)));
typedef unsigned u32x4 __attribute__((ext_vector_type(4)));
typedef unsigned u32x2 __attribute__((ext_vector_type(2)));

constexpr int D = 2048, NB = 8, SEQ = 2048, CTXL = 256;
constexpr int ML = NB * SEQ, MC = NB * CTXL, MT = ML + MC, TK = SEQ + CTXL;
constexpr int FF = 5632, INE = 3584, INO = 3904, INOP = 4096, MODW = 6 * D;
constexpr float NEPS = 1e-6f, LNEPS = 1e-5f;
constexpr float LOG2E = 1.4426950408889634f;
constexpr float LOG2_THETA = 13.287712379549449f;

constexpr size_t MiB = 1u << 20;
constexpr size_t OFF_MOD = 1 * MiB, OFF_H3 = 2 * MiB, OFF_ROPE16 = 2 * MiB + 768 * 1024, OFF_ROPE32 = 2 * MiB + 768 * 1024 + 16384;
constexpr size_t OFF_WOIN = 3 * MiB, OFF_WOOUT = 19 * MiB, OFF_WUQ = 27 * MiB, OFF_WUKV = 29 * MiB, OFF_WGU1 = 30 * MiB, OFF_WDN1 = 74 * MiB;
constexpr size_t OFF_XR = 96 * MiB;
constexpr size_t OFF_WEIN = 240 * MiB, OFF_WEOUT = 254 * MiB, OFF_WGU0 = 262 * MiB, OFF_WDN0 = 306 * MiB;
constexpr size_t OFF_H = 328 * MiB, OFF_Z = 400 * MiB, OFF_ZC = 528 * MiB, OFF_MIX = 530 * MiB;
constexpr size_t OFF_Q = 602 * MiB, OFF_K = 650 * MiB, OFF_VT = 704 * MiB, WS_END = 740 * MiB;
constexpr size_t OFF_SHW = 32 * 1024, OFF_SS = 2 * MiB + 512 * 1024;
constexpr int SHW_F0 = 0, SHW_F1 = 9 * 2 * FF, SHW_O = 2 * 9 * 2 * FF;
constexpr size_t OFF_ACT = OFF_Z;
constexpr size_t OFF_HX = 240 * MiB, OFF_FILT = 336 * MiB, OFF_QN = 368 * MiB, OFF_CKV = 384 * MiB;
constexpr int LDS_BYTES = 147456;

__device__ __forceinline__ unsigned f2bf(float f) { unsigned u = __builtin_bit_cast(unsigned, f); return (u + 0x7fffu + ((u >> 16) & 1u)) >> 16; }
__device__ __forceinline__ unsigned pk2(float lo, float hi) { return f2bf(lo) | (f2bf(hi) << 16); }
typedef __bf16 hbf16x2_t __attribute__((ext_vector_type(2)));
__device__ __forceinline__ unsigned cvtpk(float lo, float hi) { const f32x2 v = {lo, hi}; const hbf16x2_t b = __builtin_convertvector(v, hbf16x2_t); return __builtin_bit_cast(unsigned, b); }
__device__ __forceinline__ float bf2f(unsigned h) { return __builtin_bit_cast(float, h << 16); }
__device__ __forceinline__ float bflo(unsigned w) { return __builtin_bit_cast(float, w << 16); }
__device__ __forceinline__ float bfhi(unsigned w) { return __builtin_bit_cast(float, w & 0xffff0000u); }
__device__ __forceinline__ float wave_sum(float v) {
#pragma unroll
    for (int o = 1; o < 64; o <<= 1) v += __shfl_xor(v, o);
    return v;
}
__device__ __forceinline__ float siluf(float v) { return v * __builtin_amdgcn_rcpf(1.0f + __expf(-v)); }

using pg8::Unit;
typedef pg8::f32x4 gacc_t;
struct EpiStore {
    static constexpr bool PERM = true, AFTER_DRAIN = false;
    bf16_t* O; int ldc;
    const float* ss; const float* shw; int ldshw, row_off, col_off;
    __device__ __forceinline__ void operator()(const gacc_t (&acc)[2][2][4][2], const Unit& u, int wr, int wc, int fr, int fq) const {
        const int row0 = u.pm * 256 + wr * 64 + fr, col0 = u.pn * 256 + wc * 32 + 8 * fq;
        const int ra = row_off + u.pm * 256; const float* shp = shw + (ra < ML ? (ra >> 11) : 8) * ldshw + col_off + col0;
#pragma unroll
        for (int ai = 0; ai < 2; ++ai)
#pragma unroll
            for (int m = 0; m < 4; ++m) { bf16_t* rowp = O + (size_t)(row0 + ai * 128 + m * 16) * ldc + col0;
                float rs = 1.f; if (ss) rs = 1.0f / sqrtf(ss[row_off + row0 + ai * 128 + m * 16] * (1.0f / D) + NEPS);
#pragma unroll
                for (int bj = 0; bj < 2; ++bj) { gacc_t v0 = acc[ai][bj][m][0], v1 = acc[ai][bj][m][1]; u32x4 w;
                    if (ss) { const f32x4 s0 = *(const f32x4*)(shp + bj * 128), s1 = *(const f32x4*)(shp + bj * 128 + 4);
                        v0[0] = v0[0] * rs + s0.x; v0[1] = v0[1] * rs + s0.y; v0[2] = v0[2] * rs + s0.z; v0[3] = v0[3] * rs + s0.w; v1[0] = v1[0] * rs + s1.x; v1[1] = v1[1] * rs + s1.y; v1[2] = v1[2] * rs + s1.z; v1[3] = v1[3] * rs + s1.w; }
                    w.x = pg8::cvt_pk_bf16(v0[0], v0[1]); w.y = pg8::cvt_pk_bf16(v0[2], v0[3]); w.z = pg8::cvt_pk_bf16(v1[0], v1[1]); w.w = pg8::cvt_pk_bf16(v1[2], v1[3]);
                    *(u32x4*)(rowp + bj * 128) = w; } }
    }
};
struct EpiRes {
    static constexpr bool PERM = false, AFTER_DRAIN = false;
    const float* baseL; const float* baseC; float* out; const float* mod; int chunk;
    bf16_t* hu; const float* gn; const float* scl; float* ss;
    __device__ __forceinline__ void operator()(const gacc_t (&acc)[2][2][4][2], const Unit& u, int wr, int wc, int fr, int fq) const {
#pragma unroll
        for (int ai = 0; ai < 2; ++ai)
#pragma unroll
            for (int m = 0; m < 4; ++m) { const int row = u.pm * 256 + ai * 128 + wr * 64 + m * 16 + fr;
                const float* bp = row < ML ? baseL + (size_t)row * D : baseC + (size_t)(row - ML) * D;
                const int mb = row < ML ? (row >> 11) : 8; const float* gp = mod + mb * MODW + chunk * D; float* op = out + (size_t)row * D;
                float sq = 0.f;
#pragma unroll
                for (int bj = 0; bj < 2; ++bj)
#pragma unroll
                    for (int n = 0; n < 2; ++n) { const int col = u.pn * 256 + bj * 128 + wc * 32 + n * 16 + 4 * fq;
                        const f32x4 b = *(const f32x4*)(bp + col), g = *(const f32x4*)(gp + col); const gacc_t a = acc[ai][bj][m][n];
                        f32x4 o; o.x = b.x + g.x * a[0]; o.y = b.y + g.y * a[1]; o.z = b.z + g.z * a[2]; o.w = b.w + g.w * a[3];
                        *(f32x4*)(op + col) = o;
                        if (hu) { const f32x4 gg = *(const f32x4*)(gn + col), sc = *(const f32x4*)(scl + mb * MODW + col);
                            sq += (o.x * o.x + o.y * o.y) + (o.z * o.z + o.w * o.w);
                            u32x2 w; w.x = pg8::cvt_pk_bf16(o.x * gg.x * (1.f + sc.x), o.y * gg.y * (1.f + sc.y)); w.y = pg8::cvt_pk_bf16(o.z * gg.z * (1.f + sc.z), o.w * gg.w * (1.f + sc.w));
                            *(u32x2*)(hu + (size_t)row * D + col) = w; } }
                if (hu) { sq += __shfl_xor(sq, 16); sq += __shfl_xor(sq, 32); if (fq == 0) __hip_atomic_fetch_add(ss + row, sq, __ATOMIC_RELAXED, __HIP_MEMORY_SCOPE_AGENT); } }
    }
};
struct EpiSwiGLU {
    static constexpr bool PERM = true, AFTER_DRAIN = false;
    bf16_t* O; const float* ss; const float* shw;
    __device__ __forceinline__ void operator()(const gacc_t (&acc)[2][2][4][2], const Unit& u, int wr, int wc, int fr, int fq) const {
        const int row0 = u.pm * 256 + wr * 64 + fr, col0 = u.pn * 128 + wc * 32 + 8 * fq;
        const int ra = u.pm * 256; const float* shp = shw + (ra < ML ? (ra >> 11) : 8) * (2 * FF) + u.pn * 256 + wc * 32 + 8 * fq;
        const f32x4 sg0 = *(const f32x4*)shp, sg1 = *(const f32x4*)(shp + 4), su0 = *(const f32x4*)(shp + 128), su1 = *(const f32x4*)(shp + 132);
#pragma unroll
        for (int ai = 0; ai < 2; ++ai)
#pragma unroll
            for (int m = 0; m < 4; ++m) { bf16_t* rowp = O + (size_t)(row0 + ai * 128 + m * 16) * FF + col0;
                const float rs = 1.0f / sqrtf(ss[row0 + ai * 128 + m * 16] * (1.0f / D) + NEPS);
                const gacc_t a0 = acc[ai][0][m][0], a1 = acc[ai][0][m][1], b0 = acc[ai][1][m][0], b1 = acc[ai][1][m][1];
                const float g0[4] = {a0[0] * rs + sg0.x, a0[1] * rs + sg0.y, a0[2] * rs + sg0.z, a0[3] * rs + sg0.w}, g1[4] = {a1[0] * rs + sg1.x, a1[1] * rs + sg1.y, a1[2] * rs + sg1.z, a1[3] * rs + sg1.w};
                const float u0[4] = {b0[0] * rs + su0.x, b0[1] * rs + su0.y, b0[2] * rs + su0.z, b0[3] * rs + su0.w}, u1[4] = {b1[0] * rs + su1.x, b1[1] * rs + su1.y, b1[2] * rs + su1.z, b1[3] * rs + su1.w};
                u32x4 w;
                w.x = pg8::cvt_pk_bf16(siluf(g0[0]) * u0[0], siluf(g0[1]) * u0[1]); w.y = pg8::cvt_pk_bf16(siluf(g0[2]) * u0[2], siluf(g0[3]) * u0[3]);
                w.z = pg8::cvt_pk_bf16(siluf(g1[0]) * u1[0], siluf(g1[1]) * u1[1]); w.w = pg8::cvt_pk_bf16(siluf(g1[2]) * u1[2], siluf(g1[3]) * u1[3]);
                *(u32x4*)rowp = w; }
    }
};
struct EpiRopeQ {
    static constexpr bool PERM = false, AFTER_DRAIN = false;
    bf16_t* O; float qs; const float* rope;
    __device__ __forceinline__ void operator()(const gacc_t (&acc)[2][2][4][2], const Unit& u, int wr, int wc, int fr, int fq) const {
#pragma unroll
        for (int ai = 0; ai < 2; ++ai)
#pragma unroll
            for (int m = 0; m < 4; ++m) { const int row = u.pm * 256 + ai * 128 + wr * 64 + m * 16 + fr; const int t = row & (SEQ - 1);
                bf16_t* rowp = O + (size_t)row * 1536;
#pragma unroll
                for (int bj = 0; bj < 2; ++bj) { const int cgp = u.pn * 256 + bj * 128 + wc * 32; const int gi = (cgp >> 5) % 6;
                    gacc_t a = acc[ai][bj][m][0], b = acc[ai][bj][m][1];
                    if (gi >= 4) { const int pos = gi == 4 ? (t >> 6) : (t & 63); const f32x4* tp = (const f32x4*)(rope + (pos * 16 + 4 * fq) * 2); const f32x4 t0 = tp[0], t1 = tp[1];
                        const float cs[4] = {t0.x, t0.z, t1.x, t1.z}, sn[4] = {t0.y, t0.w, t1.y, t1.w};
#pragma unroll
                        for (int i = 0; i < 4; ++i) { const float x1 = a[i], x2 = b[i]; a[i] = x1 * cs[i] - x2 * sn[i]; b[i] = x1 * sn[i] + x2 * cs[i]; } }
                    u32x2 w0, w1; w0.x = pg8::cvt_pk_bf16(a[0] * qs, a[1] * qs); w0.y = pg8::cvt_pk_bf16(a[2] * qs, a[3] * qs);
                    w1.x = pg8::cvt_pk_bf16(b[0] * qs, b[1] * qs); w1.y = pg8::cvt_pk_bf16(b[2] * qs, b[3] * qs);
                    *(u32x2*)(rowp + cgp + 4 * fq) = w0; *(u32x2*)(rowp + cgp + 16 + 4 * fq) = w1; } }
    }
};
struct EpiKnope {
    static constexpr bool PERM = true, AFTER_DRAIN = false;
    bf16_t* K;
    __device__ __forceinline__ void operator()(const gacc_t (&acc)[2][2][4][2], const Unit& u, int wr, int wc, int fr, int fq) const {
        const int b = u.pm < 64 ? (u.pm >> 3) : (u.pm - 64), T0 = u.pm < 64 ? CTXL + (u.pm & 7) * 256 : 0;
#pragma unroll
        for (int ai = 0; ai < 2; ++ai)
#pragma unroll
            for (int m = 0; m < 4; ++m) { const int rin = ai * 128 + wr * 64 + m * 16 + fr; bf16_t* rowp = K + (size_t)(b * TK + T0 + rin) * 1536;
#pragma unroll
                for (int bj = 0; bj < 2; ++bj) { const int c = u.pn * 256 + bj * 128 + wc * 32 + 8 * fq; const int h = c >> 7, d = c & 127;
                    const gacc_t v0 = acc[ai][bj][m][0], v1 = acc[ai][bj][m][1]; u32x4 w;
                    w.x = pg8::cvt_pk_bf16(v0[0], v0[1]); w.y = pg8::cvt_pk_bf16(v0[2], v0[3]); w.z = pg8::cvt_pk_bf16(v1[0], v1[1]); w.w = pg8::cvt_pk_bf16(v1[2], v1[3]);
                    *(u32x4*)(rowp + h * 192 + d) = w; } }
    }
};
struct EpiVt {
    static constexpr bool PERM = true, AFTER_DRAIN = false;
    bf16_t* Vt;
    __device__ __forceinline__ void operator()(const gacc_t (&acc)[2][2][4][2], const Unit& u, int wr, int wc, int fr, int fq) const {
        const int b = u.pn < 64 ? (u.pn >> 3) : (u.pn - 64), T0 = u.pn < 64 ? CTXL + (u.pn & 7) * 256 : 0;
#pragma unroll
        for (int ai = 0; ai < 2; ++ai)
#pragma unroll
            for (int m = 0; m < 4; ++m) { const int hd = u.pm * 256 + ai * 128 + wr * 64 + m * 16 + fr; bf16_t* rowp = Vt + (size_t)(b * 1024 + hd) * TK + T0;
#pragma unroll
                for (int bj = 0; bj < 2; ++bj) { const int cin = bj * 128 + wc * 32 + 8 * fq;
                    const gacc_t v0 = acc[ai][bj][m][0], v1 = acc[ai][bj][m][1]; u32x4 w;
                    w.x = pg8::cvt_pk_bf16(v0[0], v0[1]); w.y = pg8::cvt_pk_bf16(v0[2], v0[3]); w.z = pg8::cvt_pk_bf16(v1[0], v1[1]); w.w = pg8::cvt_pk_bf16(v1[2], v1[3]);
                    *(u32x4*)(rowp + cin) = w; } }
    }
};

__device__ __forceinline__ void transpose_item(const float* W, int K, int N, bf16_t* WT, int drow0, int k0, int n0, LAS float* scr, int lane) {
    f32x4 wv[8];
#pragma unroll
    for (int i = 0; i < 8; ++i) wv[i] = *(const f32x4*)(W + (size_t)(k0 + 8 * i + (lane >> 3)) * N + n0 + 4 * (lane & 7));
#pragma unroll
    for (int i = 0; i < 8; ++i) { LAS float* sp = scr + (8 * i + (lane >> 3)) * 33 + 4 * (lane & 7); sp[0] = wv[i].x; sp[1] = wv[i].y; sp[2] = wv[i].z; sp[3] = wv[i].w; }
    asm volatile("s_waitcnt lgkmcnt(0)" ::: "memory");
    const int c = lane & 7;
#pragma unroll
    for (int j = 0; j < 4; ++j) { const int n = (lane >> 3) + 8 * j; const LAS float* s = scr + (8 * c) * 33 + n;
        u32x4 o; o.x = pk2(s[0 * 33], s[1 * 33]); o.y = pk2(s[2 * 33], s[3 * 33]); o.z = pk2(s[4 * 33], s[5 * 33]); o.w = pk2(s[6 * 33], s[7 * 33]);
        *(u32x4*)(WT + (size_t)(drow0 + n) * K + k0 + 8 * c) = o; }
    asm volatile("s_waitcnt lgkmcnt(0)" ::: "memory");
}
__device__ __forceinline__ int rowmap(int mode, int n) {
    if (mode == 0) return n;
    if (mode == 1) return 256 * (n >> 7) + (n & 127);
    if (mode == 2) return 256 * (n >> 7) + 128 + (n & 127);
    const int h = n >> 8, d = n & 255; return d < 128 ? h * 128 + d : 1024 + h * 128 + (d - 128);
}
__device__ __forceinline__ void transpose_job(const float* W, int K, int N, bf16_t* WT, int mode, int item, LAS float* scr, int lane) {
    const int nblk = N >> 5, kb = item / nblk, nb = item - kb * nblk;
    transpose_item(W, K, N, WT, rowmap(mode, nb * 32), kb * 64, nb * 32, scr, lane);
}

#define MFMA32(a, b, c) __builtin_amdgcn_mfma_f32_32x32x16_bf16((a), (b), (c), 0, 0, 0)
#define ATT_BAR() asm volatile("s_waitcnt lgkmcnt(0)\n\ts_barrier" ::: "memory")
template <int DK>
__device__ __forceinline__ void attn_unit(LAS unsigned char* lds, const bf16_t* Qp, int q_stride, const bf16_t* Kp, int k_stride, const bf16_t* Vtp, int nkeys, bf16_t* Op, int o_stride, int tid) {
    constexpr int KS = DK * 2 + 16, VS = 144, KCH = DK / 8, KPASS = 64 * KCH / 512, NS = DK / 16, KB = 64 * KS, VB = 128 * VS;
    const int wave = tid >> 6, lane = tid & 63, ql = lane & 31, hi = lane >> 5;
    constexpr int NSR = DK == 128 ? 8 : 6, NSL = NS - NSR, QRS = NSL * 32 + 16;
    LAS unsigned char* Ql = lds + 2 * KB + 2 * VB + wave * (32 * QRS);
    bf16x8 qf[NSR];
    { const bf16_t* qrow = Qp + (size_t)(wave * 32 + ql) * q_stride + 8 * hi;
#pragma unroll
      for (int s = 0; s < NSR; ++s) qf[s] = *(const bf16x8*)(qrow + 16 * s);
#pragma unroll
      for (int s = 0; s < NSL; ++s) *(LAS bf16x8*)(Ql + ql * QRS + (16 * s + 8 * hi) * 2) = *(const bf16x8*)(qrow + 16 * (NSR + s)); }
    f32x16 o[4];
#pragma unroll
    for (int d = 0; d < 4; ++d)
#pragma unroll
        for (int r = 0; r < 16; ++r) o[d][r] = 0.f;
    float m_run = -1e30f, l_run = 0.f;
    const int ntiles = nkeys >> 6;
    u32x4 kreg[KPASS], vreg[2];
#define KSRC(p) ((((p) * 512 + tid) / KCH) * k_stride + (((p) * 512 + tid) % KCH) * 8)
#define KDST(p) ((((p) * 512 + tid) / KCH) * KS + (((p) * 512 + tid) % KCH) * 16)
#define VSRC(p) ((((p) * 512 + tid) >> 3) * TK + (((p) * 512 + tid) & 7) * 8)
#define VDST(p) ((((p) * 512 + tid) >> 3) * VS + ((((p) * 512 + tid) & 7) >> 1) * 32 + ((((p) * 512 + tid) & 1) * 8))
#define K_LOAD(T) do { const bf16_t* kn_ = Kp + (size_t)(T) * 64 * k_stride; _Pragma("unroll") for (int p = 0; p < KPASS; ++p) kreg[p] = *(const u32x4*)(kn_ + KSRC(p)); } while (0)
#define V_LOAD(T) do { const bf16_t* vn_ = Vtp + (T) * 64; _Pragma("unroll") for (int p = 0; p < 2; ++p) vreg[p] = *(const u32x4*)(vn_ + VSRC(p)); } while (0)
#define K_WRITE(BUF) do { LAS unsigned char* kl_ = lds + (BUF) * KB; _Pragma("unroll") for (int p = 0; p < KPASS; ++p) *(LAS u32x4*)(kl_ + KDST(p)) = kreg[p]; } while (0)
#define V_WRITE(BUF) do { LAS unsigned char* vl_ = lds + 2 * KB + (BUF) * VB; _Pragma("unroll") for (int p = 0; p < 2; ++p) { *(LAS u32x2*)(vl_ + VDST(p)) = (u32x2){vreg[p].x, vreg[p].y}; *(LAS u32x2*)(vl_ + VDST(p) + 16) = (u32x2){vreg[p].z, vreg[p].w}; } } while (0)
#define QKT(BUF, D0, D1) do { const LAS unsigned char* Kl_ = lds + (BUF) * KB; \
        _Pragma("unroll") for (int r = 0; r < 16; ++r) { D0[r] = 0.f; D1[r] = 0.f; } \
        _Pragma("unroll") for (int s_ = 0; s_ < NS; ++s_) { \
            const bf16x8 a0_ = *(const LAS bf16x8*)(Kl_ + ql * KS + (16 * s_ + 8 * hi) * 2), a1_ = *(const LAS bf16x8*)(Kl_ + (32 + ql) * KS + (16 * s_ + 8 * hi) * 2); \
            bf16x8 qv_; if (s_ < NSR) qv_ = qf[s_ < NSR ? s_ : 0]; else qv_ = *(const LAS bf16x8*)(Ql + ql * QRS + (16 * (s_ - NSR) + 8 * hi) * 2); \
            D0 = MFMA32(a0_, qv_, D0); D1 = MFMA32(a1_, qv_, D1); } } while (0)
#define FINISH_SM(S0, S1) do { float ls_ = 0.f; \
        _Pragma("unroll") for (int r = 0; r < 16; ++r) { S0[r] = __builtin_amdgcn_exp2f(S0[r] - m_run); S1[r] = __builtin_amdgcn_exp2f(S1[r] - m_run); ls_ += S0[r] + S1[r]; } \
        l_run += ls_; \
        _Pragma("unroll") for (int st = 0; st < 2; ++st) { u32x4 w0_, w1_; \
            w0_.x = cvtpk(S0[8 * st + 0], S0[8 * st + 1]); w0_.y = cvtpk(S0[8 * st + 2], S0[8 * st + 3]); w0_.z = cvtpk(S0[8 * st + 4], S0[8 * st + 5]); w0_.w = cvtpk(S0[8 * st + 6], S0[8 * st + 7]); \
            w1_.x = cvtpk(S1[8 * st + 0], S1[8 * st + 1]); w1_.y = cvtpk(S1[8 * st + 2], S1[8 * st + 3]); w1_.z = cvtpk(S1[8 * st + 4], S1[8 * st + 5]); w1_.w = cvtpk(S1[8 * st + 6], S1[8 * st + 7]); \
            pa[0][st] = __builtin_bit_cast(bf16x8, w0_); pa[1][st] = __builtin_bit_cast(bf16x8, w1_); } } while (0)
#define PV(BUF) do { const LAS unsigned char* Vl_ = lds + 2 * KB + (BUF) * VB; \
        _Pragma("unroll") for (int c_ = 0; c_ < 4; ++c_) _Pragma("unroll") for (int dt = 0; dt < 4; ++dt) { \
            const bf16x8 av_ = *(const LAS bf16x8*)(Vl_ + (32 * dt + ql) * VS + c_ * 32 + hi * 16); o[dt] = MFMA32(av_, pa[c_ >> 1][c_ & 1], o[dt]); } } while (0)
#define ROWMAX(S0, S1, MX) do { MX = S0[0]; _Pragma("unroll") for (int r = 1; r < 16; ++r) MX = fmaxf(MX, S0[r]); _Pragma("unroll") for (int r = 0; r < 16; ++r) MX = fmaxf(MX, S1[r]); MX = fmaxf(MX, __shfl_xor(MX, 32)); } while (0)
#define RESCALE(MX) do { const float mn_ = fmaxf(m_run, MX); if (__builtin_amdgcn_ballot_w64(mn_ > m_run) != 0ull) { const float al_ = __builtin_amdgcn_exp2f(m_run - mn_); l_run *= al_; \
        _Pragma("unroll") for (int d = 0; d < 4; ++d) _Pragma("unroll") for (int r = 0; r < 16; ++r) o[d][r] *= al_; } m_run = mn_; } while (0)
    f32x16 sA0, sA1, sB0, sB1; bf16x8 pa[2][2]; float mx;
    K_LOAD(0); V_LOAD(0); K_WRITE(0);
    if (ntiles > 1) K_LOAD(1);
    ATT_BAR();
    QKT(0, sA0, sA1);
    if (ntiles > 1) { K_WRITE(1); if (ntiles > 2) K_LOAD(2); }
    V_WRITE(0); if (ntiles > 1) V_LOAD(1);
    ROWMAX(sA0, sA1, mx); RESCALE(mx);
    ATT_BAR();
    for (int j = 1; j < ntiles; ++j) {
        const int kb = j & 1;
        QKT(kb, sB0, sB1);
        FINISH_SM(sA0, sA1);
#pragma unroll
        for (int i_ = 0; i_ < NS * 2; ++i_) { __builtin_amdgcn_sched_group_barrier(0x008, 1, 0); __builtin_amdgcn_sched_group_barrier(0x100, 1, 0); __builtin_amdgcn_sched_group_barrier(0x002, 5, 0); }
        __builtin_amdgcn_sched_barrier(0);
        if (j + 1 < ntiles) { K_WRITE(kb ^ 1); if (j + 2 < ntiles) K_LOAD(j + 2); }
        V_WRITE(kb); if (j + 1 < ntiles) V_LOAD(j + 1);
        __builtin_amdgcn_sched_barrier(0);
        PV(kb ^ 1);
        ROWMAX(sB0, sB1, mx);
#pragma unroll
        for (int i_ = 0; i_ < 16; ++i_) { __builtin_amdgcn_sched_group_barrier(0x008, 1, 0); __builtin_amdgcn_sched_group_barrier(0x100, 1, 0); __builtin_amdgcn_sched_group_barrier(0x002, 2, 0); }
        __builtin_amdgcn_sched_barrier(0);
        RESCALE(mx);
        sA0 = sB0; sA1 = sB1;
        ATT_BAR();
    }
    FINISH_SM(sA0, sA1);
    PV((ntiles - 1) & 1);
    ATT_BAR();
#undef KSRC
#undef KDST
#undef VSRC
#undef VDST
    const float lt = l_run + __shfl_xor(l_run, 32), il = 1.0f / lt;
    bf16_t* orow = Op + (size_t)(wave * 32 + ql) * o_stride;
#pragma unroll
    for (int dt = 0; dt < 4; ++dt)
#pragma unroll
        for (int g = 0; g < 4; ++g) { u32x2 w; w.x = cvtpk(o[dt][4 * g] * il, o[dt][4 * g + 1] * il); w.y = cvtpk(o[dt][4 * g + 2] * il, o[dt][4 * g + 3] * il);
            *(u32x2*)(orow + 32 * dt + 8 * g + 4 * hi) = w; }
}

template <int DK>
__device__ __forceinline__ void attn_unit_simple(LAS unsigned char* lds, const bf16_t* Qp, int q_stride, const bf16_t* Kp, int k_stride, const bf16_t* Vtp, int nkeys, bf16_t* Op, int o_stride, int tid) {
    constexpr int KS = DK * 2 + 16, VS = 144, KCH = DK / 8, KPASS = 64 * KCH / 512, NS = DK / 16, TILE_B = 64 * KS + 128 * VS;
    const int wave = tid >> 6, lane = tid & 63, ql = lane & 31, hi = lane >> 5;
    constexpr int NSR = DK == 128 ? 8 : 6, NSL = NS - NSR, QRS = NSL * 32 + 16;
    LAS unsigned char* Ql = lds + 2 * TILE_B + wave * (32 * QRS);
    bf16x8 qf[NSR];
    { const bf16_t* qrow = Qp + (size_t)(wave * 32 + ql) * q_stride + 8 * hi;
#pragma unroll
      for (int s = 0; s < NSR; ++s) qf[s] = *(const bf16x8*)(qrow + 16 * s);
#pragma unroll
      for (int s = 0; s < NSL; ++s) *(LAS bf16x8*)(Ql + ql * QRS + (16 * s + 8 * hi) * 2) = *(const bf16x8*)(qrow + 16 * (NSR + s)); }
    f32x16 o[4];
#pragma unroll
    for (int d = 0; d < 4; ++d)
#pragma unroll
        for (int r = 0; r < 16; ++r) o[d][r] = 0.f;
    float m_run = -1e30f, l_run = 0.f;
    const int ntiles = nkeys >> 6;
    u32x4 kreg[KPASS], vreg[2];
#define KSRC(p) ((((p) * 512 + tid) / KCH) * k_stride + (((p) * 512 + tid) % KCH) * 8)
#define KDST(p) ((((p) * 512 + tid) / KCH) * KS + (((p) * 512 + tid) % KCH) * 16)
#define VSRC(p) ((((p) * 512 + tid) >> 3) * TK + (((p) * 512 + tid) & 7) * 8)
#define VDST(p) ((((p) * 512 + tid) >> 3) * VS + ((((p) * 512 + tid) & 7) >> 1) * 32 + ((((p) * 512 + tid) & 1) * 8))
#define ATT_LOAD(T) do { const bf16_t* kn_ = Kp + (size_t)(T) * 64 * k_stride; const bf16_t* vn_ = Vtp + (T) * 64; \
        _Pragma("unroll") for (int p = 0; p < KPASS; ++p) kreg[p] = *(const u32x4*)(kn_ + KSRC(p)); \
        _Pragma("unroll") for (int p = 0; p < 2; ++p) vreg[p] = *(const u32x4*)(vn_ + VSRC(p)); } while (0)
#define ATT_WRITE(BUF) do { LAS unsigned char* kl_ = lds + (BUF) * TILE_B; LAS unsigned char* vl_ = kl_ + 64 * KS; \
        _Pragma("unroll") for (int p = 0; p < KPASS; ++p) *(LAS u32x4*)(kl_ + KDST(p)) = kreg[p]; \
        _Pragma("unroll") for (int p = 0; p < 2; ++p) { *(LAS u32x2*)(vl_ + VDST(p)) = (u32x2){vreg[p].x, vreg[p].y}; *(LAS u32x2*)(vl_ + VDST(p) + 16) = (u32x2){vreg[p].z, vreg[p].w}; } } while (0)
    if (wave < 4) __builtin_amdgcn_s_setprio(2);
    ATT_LOAD(0); ATT_WRITE(0);
    if (ntiles > 1) ATT_LOAD(1);
    ATT_BAR();
    for (int tile = 0; tile < ntiles; ++tile) {
        const int cur = tile & 1;
        if (tile + 1 < ntiles) { ATT_WRITE(cur ^ 1); if (tile + 2 < ntiles) ATT_LOAD(tile + 2); }
        LAS unsigned char* Kl = lds + cur * TILE_B; LAS unsigned char* Vl = Kl + 64 * KS;
        f32x16 s0, s1;
#pragma unroll
        for (int r = 0; r < 16; ++r) { s0[r] = 0.f; s1[r] = 0.f; }
        bf16x8 kf[2][4], qx[2][2];
#define LOADK(BUF, GI) _Pragma("unroll") for (int j = 0; j < 2; ++j) { const int s_ = 2 * (GI) + j; \
            kf[BUF][2 * j] = *(const LAS bf16x8*)(Kl + ql * KS + (16 * s_ + 8 * hi) * 2); kf[BUF][2 * j + 1] = *(const LAS bf16x8*)(Kl + (32 + ql) * KS + (16 * s_ + 8 * hi) * 2); \
            if (s_ >= NSR) qx[BUF][j] = *(const LAS bf16x8*)(Ql + ql * QRS + (16 * (s_ - NSR) + 8 * hi) * 2); }
        LOADK(0, 0)
#pragma unroll
        for (int gi = 0; gi < NS / 2; ++gi) {
            if (gi + 1 < NS / 2) { LOADK((gi + 1) & 1, gi + 1) }
            __builtin_amdgcn_sched_barrier(0);
#pragma unroll
            for (int j = 0; j < 2; ++j) { const int s_ = 2 * gi + j; const bf16x8 qv = s_ < NSR ? qf[s_ < NSR ? s_ : 0] : qx[gi & 1][j];
                s0 = MFMA32(kf[gi & 1][2 * j], qv, s0); s1 = MFMA32(kf[gi & 1][2 * j + 1], qv, s1); }
            __builtin_amdgcn_sched_barrier(0);
        }
#undef LOADK
        u32x4 vf[2][4];
#define LOADV(BUF, CC) _Pragma("unroll") for (int d_ = 0; d_ < 4; ++d_) vf[BUF][d_] = *(const LAS u32x4*)(Vl + (32 * d_ + ql) * VS + (CC) * 32 + hi * 16);
        LOADV(0, 0)
        __builtin_amdgcn_sched_barrier(0);
        float mx = s0[0];
#pragma unroll
        for (int r = 1; r < 16; ++r) mx = fmaxf(mx, s0[r]);
#pragma unroll
        for (int r = 0; r < 16; ++r) mx = fmaxf(mx, s1[r]);
        mx = fmaxf(mx, __shfl_xor(mx, 32));
        const float m_new = fmaxf(m_run, mx);
        if (__builtin_amdgcn_ballot_w64(m_new > m_run) != 0ull) {
            const float alpha = __builtin_amdgcn_exp2f(m_run - m_new);
            l_run *= alpha;
#pragma unroll
            for (int d = 0; d < 4; ++d)
#pragma unroll
                for (int r = 0; r < 16; ++r) o[d][r] *= alpha;
        }
        float ls = 0.f;
#pragma unroll
        for (int r = 0; r < 16; ++r) { s0[r] = __builtin_amdgcn_exp2f(s0[r] - m_new); s1[r] = __builtin_amdgcn_exp2f(s1[r] - m_new); ls += s0[r] + s1[r]; }
        l_run += ls; m_run = m_new;
        bf16x8 pa[2][2];
#pragma unroll
        for (int st = 0; st < 2; ++st) {
            u32x4 w0, w1;
            w0.x = cvtpk(s0[8 * st + 0], s0[8 * st + 1]); w0.y = cvtpk(s0[8 * st + 2], s0[8 * st + 3]); w0.z = cvtpk(s0[8 * st + 4], s0[8 * st + 5]); w0.w = cvtpk(s0[8 * st + 6], s0[8 * st + 7]);
            w1.x = cvtpk(s1[8 * st + 0], s1[8 * st + 1]); w1.y = cvtpk(s1[8 * st + 2], s1[8 * st + 3]); w1.z = cvtpk(s1[8 * st + 4], s1[8 * st + 5]); w1.w = cvtpk(s1[8 * st + 6], s1[8 * st + 7]);
            pa[0][st] = __builtin_bit_cast(bf16x8, w0); pa[1][st] = __builtin_bit_cast(bf16x8, w1);
        }
        __builtin_amdgcn_sched_barrier(0);
#pragma unroll
        for (int dt = 0; dt < 4; ++dt) {
            if (dt < 3) { LOADV((dt + 1) & 1, dt + 1) }
            __builtin_amdgcn_sched_barrier(0);
#pragma unroll
            for (int d_ = 0; d_ < 4; ++d_) o[d_] = MFMA32(__builtin_bit_cast(bf16x8, vf[dt & 1][d_]), pa[dt >> 1][dt & 1], o[d_]);
            __builtin_amdgcn_sched_barrier(0);
        }
#undef LOADV
        ATT_BAR();
    }
    __builtin_amdgcn_s_setprio(0);
    const float lt = l_run + __shfl_xor(l_run, 32), il = 1.0f / lt;
    bf16_t* orow = Op + (size_t)(wave * 32 + ql) * o_stride;
#pragma unroll
    for (int dt = 0; dt < 4; ++dt)
#pragma unroll
        for (int g = 0; g < 4; ++g) { u32x2 w; w.x = cvtpk(o[dt][4 * g] * il, o[dt][4 * g + 1] * il); w.y = cvtpk(o[dt][4 * g + 2] * il, o[dt][4 * g + 3] * il);
            *(u32x2*)(orow + 32 * dt + 8 * g + 4 * hi) = w; }
}

#define XB_TMO      128
#define XB_XCNT(j)  (256  + 64 * (j))
#define XB_XSUB(j)  (1280 + 64 * (j))
#define XB_XGEN(j)  (2304 + 64 * (j))
#define XB_TOP      3328
#define XB_TOPGEN   3392
#define XCD_BAR_WORDS 3456
#define XB_SPIN_CAP (1u << 18)

__device__ __forceinline__ unsigned xb_ld(unsigned* p)              { return __hip_atomic_load(p, __ATOMIC_RELAXED, __HIP_MEMORY_SCOPE_AGENT); }
__device__ __forceinline__ unsigned xb_add(unsigned* p, unsigned v) { return __hip_atomic_fetch_add(p, v, __ATOMIC_RELAXED, __HIP_MEMORY_SCOPE_AGENT); }
__device__ __forceinline__ unsigned xb_xcc_id() { return (unsigned)__builtin_amdgcn_s_getreg((3 << 11) | 20) & 0xFu; }
#define XB_SPIN(cond, bar) do { unsigned _sp = 0; while (cond) { __builtin_amdgcn_s_sleep(1); \
    if ((++_sp & 255u) == 0u) { if (xb_ld(&(bar)[XB_TMO])) break; if (_sp > XB_SPIN_CAP) { atomicAdd(&(bar)[XB_TMO], 1u); break; } } } } while (0)

struct XcdBarrier {
    unsigned* bar; unsigned x;
    volatile LAS unsigned* st;
};

__device__ __forceinline__ XcdBarrier xcd_barrier_post(unsigned* bar, volatile LAS unsigned* st) {
    XcdBarrier b; b.bar = bar; b.x = xb_xcc_id(); b.st = st;
    if (threadIdx.x == 0) (void)xb_add(&bar[XB_XCNT(b.x)], 1u);
    return b;
}
__device__ __forceinline__ void xcd_barrier_complete(unsigned* bar, unsigned x, unsigned& nloc, unsigned& nx) {
    const unsigned G = gridDim.x * gridDim.y * gridDim.z;
    unsigned sum, cnt, mine, sp = 0u;
    for (;;) {
        sum = 0u; cnt = 0u; mine = 0u;
#pragma unroll
        for (unsigned j = 0; j < 16; ++j) { const unsigned c = xb_ld(&bar[XB_XCNT(j)]); sum += c; cnt += (c > 0u) ? 1u : 0u; mine = (j == x) ? c : mine; }
        if (sum == G) break;
        __builtin_amdgcn_s_sleep(1);
        if ((++sp & 255u) == 0u) { if (xb_ld(&bar[XB_TMO])) break; if (sp > XB_SPIN_CAP) { atomicAdd(&bar[XB_TMO], 1u); break; } }
    }
    nloc = mine > 0u ? mine : 1u; nx = cnt > 0u ? cnt : 1u;
}

__device__ __forceinline__ void xcd_barrier(const XcdBarrier& b) {
    asm volatile("s_waitcnt vmcnt(0)" ::: "memory");
    __syncthreads();
    if (threadIdx.x == 0) {
        unsigned* bar = b.bar;
        __builtin_amdgcn_s_waitcnt(0);
        unsigned nloc = b.st[0], nx = b.st[1];
        if (nloc == 0u) { xcd_barrier_complete(bar, b.x, nloc, nx); b.st[0] = nloc; b.st[1] = nx; }
        const unsigned old = xb_add(&bar[XB_XSUB(b.x)], 1u);
        const unsigned gen = old / nloc;
        if (old + 1u == (gen + 1u) * nloc) {
            __builtin_amdgcn_fence(__ATOMIC_RELEASE, "agent");
            asm volatile("s_waitcnt vmcnt(0)" ::: "memory");
            const unsigned og = xb_add(&bar[XB_TOP], 1u);
            const unsigned tg = og / nx;
            if (og + 1u == (tg + 1u) * nx) xb_add(&bar[XB_TOPGEN], 1u);
            else XB_SPIN(xb_ld(&bar[XB_TOPGEN]) == tg, bar);
            __builtin_amdgcn_fence(__ATOMIC_ACQUIRE, "agent");
            xb_add(&bar[XB_XGEN(b.x)], 1u);
            asm volatile("s_waitcnt vmcnt(0)" ::: "memory");
        } else {
            XB_SPIN(xb_ld(&bar[XB_XGEN(b.x)]) == gen, bar);
            __builtin_amdgcn_fence(__ATOMIC_ACQUIRE, "agent");
            asm volatile("s_waitcnt vmcnt(0)" ::: "memory");
        }
    }
    __syncthreads();
}


struct Args { const float* in[37]; float* out; unsigned char* ws; int ph_lo, ph_hi; };
constexpr int NPHASE = 19;
#ifndef PHMASK
#define PHMASK 0xFFFFFFFFu
#endif
#define EN(k) (((PHMASK) >> (k)) & 1u)
#ifndef SUBMASK
#define SUBMASK 0xFFFFFFFFu
#endif
#define SUB(k) (((SUBMASK) >> (k)) & 1u)

template <int PH>
__device__ __forceinline__ void run_phase(const Args& args, LAS unsigned char* lds) {
    constexpr int ph = PH;
    const int tid = threadIdx.x, lane = tid & 63, wave = __builtin_amdgcn_readfirstlane(tid >> 6);
    const int G = gridDim.x, bid = blockIdx.x;
    const int gw = bid * 8 + wave, NGW = G * 8;
    unsigned char* ws = args.ws;
    const float* x_in = args.in[0]; const float* ctx_in = args.in[2];
    float* MOD = (float*)(ws + OFF_MOD); float* H3 = (float*)(ws + OFF_H3); float* XR = (float*)(ws + OFF_XR);
    bf16_t* Hb = (bf16_t*)(ws + OFF_H); bf16_t* Zb = (bf16_t*)(ws + OFF_Z); bf16_t* ZCb = (bf16_t*)(ws + OFF_ZC); bf16_t* MIXb = (bf16_t*)(ws + OFF_MIX);
    bf16_t* ACTb = (bf16_t*)(ws + OFF_ACT); bf16_t* Qb = (bf16_t*)(ws + OFF_Q); bf16_t* Kb = (bf16_t*)(ws + OFF_K); bf16_t* VTb = (bf16_t*)(ws + OFF_VT);
    bf16_t* HXb = (bf16_t*)(ws + OFF_HX); float* FILT = (float*)(ws + OFF_FILT); bf16_t* QNb = (bf16_t*)(ws + OFF_QN); bf16_t* CKVb = (bf16_t*)(ws + OFF_CKV);
    (void)lane; (void)gw; (void)NGW; (void)x_in; (void)ctx_in; (void)MOD; (void)H3; (void)XR; (void)Hb; (void)Zb; (void)ZCb; (void)MIXb; (void)ACTb; (void)Qb; (void)Kb; (void)VTb; (void)HXb; (void)FILT; (void)QNb; (void)CKVb;

        if (EN(0) && ph == 0) {
            {
                LAS float* scr = (LAS float*)(lds + wave * 16384);
                constexpr int I0 = 32 * 112, I1 = 32 * 64, I2 = 32 * 122, I3 = 32 * 64, I4 = 8 * 48, I5 = 4 * 64, IG = 32 * 176, ID = 88 * 64;
                constexpr int NIT = I0 + I1 + I2 + I3 + I4 + I5 + 4 * IG + 2 * ID;
                for (int it = gw; it < NIT; it += NGW) {
                    int r = it;
                    if (r < I0) { transpose_job(args.in[8], D, INE, (bf16_t*)(ws + OFF_WEIN), 0, r, scr, lane); continue; } r -= I0;
                    if (r < I1) { transpose_job(args.in[9], D, D, (bf16_t*)(ws + OFF_WEOUT), 0, r, scr, lane); continue; } r -= I1;
                    if (r < I2) { transpose_job(args.in[16], D, INO, (bf16_t*)(ws + OFF_WOIN), 0, r, scr, lane); continue; } r -= I2;
                    if (r < I3) { transpose_job(args.in[17], D, D, (bf16_t*)(ws + OFF_WOOUT), 0, r, scr, lane); continue; } r -= I3;
                    if (r < I4) { transpose_job(args.in[31], 512, 1536, (bf16_t*)(ws + OFF_WUQ), 0, r, scr, lane); continue; } r -= I4;
                    if (r < I5) { transpose_job(args.in[32], 256, 2048, (bf16_t*)(ws + OFF_WUKV), 3, r, scr, lane); continue; } r -= I5;
                    if (r < IG) { transpose_job(args.in[33], D, FF, (bf16_t*)(ws + OFF_WGU0), 1, r, scr, lane); continue; } r -= IG;
                    if (r < IG) { transpose_job(args.in[34], D, FF, (bf16_t*)(ws + OFF_WGU0), 2, r, scr, lane); continue; } r -= IG;
                    if (r < IG) { transpose_job(args.in[33] + (size_t)D * FF, D, FF, (bf16_t*)(ws + OFF_WGU1), 1, r, scr, lane); continue; } r -= IG;
                    if (r < IG) { transpose_job(args.in[34] + (size_t)D * FF, D, FF, (bf16_t*)(ws + OFF_WGU1), 2, r, scr, lane); continue; } r -= IG;
                    if (r < ID) { transpose_job(args.in[35], FF, D, (bf16_t*)(ws + OFF_WDN0), 0, r, scr, lane); continue; } r -= ID;
                    transpose_job(args.in[35] + (size_t)FF * D, FF, D, (bf16_t*)(ws + OFF_WDN1), 0, r, scr, lane);
                }
                { u32x4* zp = (u32x4*)((bf16_t*)(ws + OFF_WOIN) + (size_t)INO * D); const int nz = (INOP - INO) * D / 8;
                  for (int i = bid * 512 + tid; i < nz; i += G * 512) zp[i] = (u32x4){0u, 0u, 0u, 0u}; }
            }
            __syncthreads();
            {
                LAS float* cond = (LAS float*)lds; LAS float* red = (LAS float*)(lds + 9 * 2048 * 4);
                for (int idx = tid; idx < 9 * 2048; idx += 512) { const int r = idx >> 11, k = idx & 2047; const float v = r < 8 ? args.in[1][r * 2048 + k] : args.in[3][k]; cond[idx] = v / (1.0f + expf(-v)); }
                __syncthreads();
                for (int unit = bid; unit < 256; unit += G) {
                    const int layer = unit >> 7, col0 = (unit & 127) * 96;
                    if (tid < 384) {
                        const int cg4 = tid % 24, ks = tid / 24;
                        const float* wp = args.in[4] + ((size_t)layer * 2048 + ks * 128) * MODW + col0 + cg4 * 4;
                        const LAS float* cp = cond + ks * 128;
                        f32x4 acc[9];
#pragma unroll
                        for (int r = 0; r < 9; ++r) acc[r] = (f32x4){0.f, 0.f, 0.f, 0.f};
#pragma unroll 8
                        for (int kk = 0; kk < 128; ++kk) { const f32x4 w = *(const f32x4*)(wp + (size_t)kk * MODW);
#pragma unroll
                            for (int r = 0; r < 9; ++r) { const float cv = cp[r * 2048 + kk]; acc[r] += w * cv; } }
#pragma unroll
                        for (int r = 0; r < 9; ++r) *(LAS f32x4*)(red + (ks * 9 + r) * 96 + cg4 * 4) = acc[r];
                    }
                    __syncthreads();
                    for (int idx = tid; idx < 9 * 96; idx += 512) { const int r = idx / 96, cc = idx - r * 96; float s = 0.f;
#pragma unroll
                        for (int ks = 0; ks < 16; ++ks) s += red[(ks * 9 + r) * 96 + cc];
                        MOD[(layer * 9 + r) * MODW + col0 + cc] = s + args.in[5][layer * MODW + col0 + cc]; }
                    __syncthreads();
                }
            }
            { float* ssz = (float*)(ws + OFF_SS); for (int i = bid * 512 + tid; i < 3 * MT; i += G * 512) ssz[i] = 0.f; }
            {
                { float* rt = (float*)(ws + OFF_ROPE32);
                  for (int i = bid * 512 + tid; i < 64 * 32; i += G * 512) { const int pos = i >> 5, jj = i & 31; const float ang = (float)pos * exp2f(-(float)jj * (LOG2_THETA / 32.0f)); rt[2 * i] = cosf(ang); rt[2 * i + 1] = sinf(ang); } }
                { float* rt = (float*)(ws + OFF_ROPE16);
                  for (int i = bid * 512 + tid; i < 64 * 16; i += G * 512) { const int pos = i >> 4, jj = i & 15; const float ang = (float)pos * exp2f(-(float)jj * (LOG2_THETA / 16.0f)); rt[2 * i] = cosf(ang); rt[2 * i + 1] = sinf(ang); } }
                const float* w1 = args.in[20]; const float* b1 = args.in[21]; const float* w2 = args.in[22]; const float* b2 = args.in[23];
                const float* w3 = args.in[24]; const float* b3 = args.in[25]; const float* fr = args.in[27];
                for (int pos = gw; pos < SEQ; pos += NGW) {
                    const float tl = (float)pos / (float)(SEQ - 1), wt = (6.283185307179586f / (float)SEQ) * (float)pos;
                    float a = b1[lane] + tl * w1[lane];
                    for (int i = 0; i < 16; ++i) { const float f = 1e-4f + (float)i * ((15.0f - 1e-4f) / 15.0f); const float ang = f * wt;
                        a += cosf(ang) * w1[(1 + i) * 64 + lane] - sinf(ang) * w1[(17 + i) * 64 + lane]; }
                    const float h1 = sinf(fr[lane] * a);
                    float a2 = b2[lane];
                    for (int i = 0; i < 64; ++i) a2 += __shfl(h1, i) * w2[i * 64 + lane];
                    const float h2 = sinf(fr[64 + lane] * a2);
                    float a3 = b3[lane];
                    for (int i = 0; i < 64; ++i) a3 += __shfl(h2, i) * w3[i * 64 + lane];
                    H3[pos * 64 + lane] = sinf(fr[128 + lane] * a3);
                }
            }
        }
        if (EN(1) && (ph == 1 || ph == 6 || ph == 9 || ph == 15)) {
            const int layer = ph >= 9 ? 1 : 0; const bool ffn = (ph == 6 || ph == 15);
            const float* g = (ffn ? args.in[7] : args.in[6]) + layer * D;
            const float* srcL = ph == 1 ? x_in : XR; const float* srcC = ph == 1 ? ctx_in : XR + (size_t)ML * D;
            const float* modL = MOD + layer * 9 * MODW + (ffn ? 3 : 0) * D;
            const int rend = ph == 15 ? ML : MT;
            f32x4 v[8], nv[8];
            if (gw < rend) { const float* xr = gw < ML ? srcL + (size_t)gw * D : srcC + (size_t)(gw - ML) * D;
#pragma unroll
                for (int j = 0; j < 8; ++j) v[j] = ((const f32x4*)xr)[lane + 64 * j]; }
            for (int row = gw; row < rend; row += NGW) {
                const int nrow = row + NGW;
                if (nrow < rend) { const float* xn = nrow < ML ? srcL + (size_t)nrow * D : srcC + (size_t)(nrow - ML) * D;
#pragma unroll
                    for (int j = 0; j < 8; ++j) nv[j] = ((const f32x4*)xn)[lane + 64 * j]; }
                const float* mr = modL + (row < ML ? (row >> 11) : 8) * MODW;
                float ss = 0.f;
#pragma unroll
                for (int j = 0; j < 8; ++j) ss += (v[j].x * v[j].x + v[j].y * v[j].y) + (v[j].z * v[j].z + v[j].w * v[j].w);
                const float rs = 1.0f / sqrtf(wave_sum(ss) * (1.0f / D) + NEPS);
                u32x2* op = (u32x2*)(Hb + (size_t)row * D);
#pragma unroll
                for (int j = 0; j < 8; ++j) { const int c4 = lane + 64 * j; const f32x4 gg = ((const f32x4*)g)[c4], sh = ((const f32x4*)mr)[c4], sc = ((const f32x4*)(mr + D))[c4];
                    u32x2 w; w.x = pk2(v[j].x * rs * gg.x * (1.f + sc.x) + sh.x, v[j].y * rs * gg.y * (1.f + sc.y) + sh.y);
                    w.y = pk2(v[j].z * rs * gg.z * (1.f + sc.z) + sh.z, v[j].w * rs * gg.w * (1.f + sc.w) + sh.w); op[c4] = w; }
#pragma unroll
                for (int j = 0; j < 8; ++j) v[j] = nv[j];
            }
        }
        if (EN(1) && ph == 1) {
            LAS float* shl = (LAS float*)lds;
            float* SHW = (float*)(ws + OFF_SHW);
#pragma unroll 1
            for (int job = 0; job < 3; ++job) {
                const float* shsrc = MOD + (job == 0 ? 0 : 9 * MODW) + (job == 2 ? 0 : 3) * D;
                const bf16_t* Wt = (const bf16_t*)(ws + (job == 0 ? OFF_WGU0 : job == 1 ? OFF_WGU1 : OFF_WOIN));
                const int N = job == 2 ? INOP : 2 * FF; float* dst = SHW + (job == 0 ? SHW_F0 : job == 1 ? SHW_F1 : SHW_O);
                __syncthreads();
                for (int idx = tid; idx < 9 * 512; idx += 512) { const int r = idx >> 9, k4 = idx & 511; *(LAS f32x4*)(shl + r * 2048 + k4 * 4) = *(const f32x4*)(shsrc + r * MODW + k4 * 4); }
                __syncthreads();
                for (int n = gw; n < N; n += NGW) {
                    u32x2 wv[8];
#pragma unroll
                    for (int i = 0; i < 8; ++i) wv[i] = *(const u32x2*)(Wt + (size_t)n * D + 4 * (lane + 64 * i));
                    float wf[32];
#pragma unroll
                    for (int i = 0; i < 8; ++i) { wf[4 * i] = bflo(wv[i].x); wf[4 * i + 1] = bfhi(wv[i].x); wf[4 * i + 2] = bflo(wv[i].y); wf[4 * i + 3] = bfhi(wv[i].y); }
#pragma unroll 1
                    for (int r = 0; r < 9; ++r) { float a = 0.f;
#pragma unroll
                        for (int i = 0; i < 8; ++i) { const f32x4 sv = *(const LAS f32x4*)(shl + r * 2048 + 4 * (lane + 64 * i)); a += (wf[4 * i] * sv.x + wf[4 * i + 1] * sv.y) + (wf[4 * i + 2] * sv.z + wf[4 * i + 3] * sv.w); }
                        const float t = wave_sum(a); if (lane == 0) dst[r * N + n] = t; }
                }
            }
        }
        if (EN(2) && (ph == 2 || ph == 10)) {
            const int nsub = ph == 2 ? 1 : 2;
#pragma unroll 1
            for (int sub = 0; sub < nsub; ++sub) {
                const bf16_t* A = sub ? Hb + (size_t)ML * D : Hb;
                const bf16_t* Bt = ph == 2 ? (const bf16_t*)(ws + OFF_WEIN) : (sub ? (const bf16_t*)(ws + OFF_WOIN) + (size_t)3584 * D : (const bf16_t*)(ws + OFF_WOIN));
                const int Mr = ph == 2 ? MT : (sub ? MC : ML), Nr = ph == 2 ? INE : (sub ? 512 : INOP);
                pg8::Gemm g{A, Bt, Mr, Nr, D}; pg8::StaticOrder S; S.init(Mr, Nr, G, bid);
                EpiStore E{sub ? ZCb : Zb, Nr, ph == 2 ? (const float*)nullptr : (const float*)(ws + OFF_SS) + MT, (const float*)(ws + OFF_SHW) + SHW_O, INOP, sub ? ML : 0, sub ? 3584 : 0};
                pg8::gemm_phase<EpiStore, pg8::StaticOrder, true, true>(lds, g, S, E);
            }
        }
        if (EN(3) && ph == 3) {
            if (SUB(0)) {
                const float* qg = args.in[14]; const float* kg = args.in[15];
                const int l16 = lane & 15, gq = lane >> 4;
                const float QS = 0.08838834764831845f * LOG2E;
                const f32x4 qga = *(const f32x4*)(qg + 8 * l16), qgb = *(const f32x4*)(qg + 8 * l16 + 4), kga = *(const f32x4*)(kg + 8 * l16), kgb = *(const f32x4*)(kg + 8 * l16 + 4);
                const float qgv[8] = {qga.x, qga.y, qga.z, qga.w, qgb.x, qgb.y, qgb.z, qgb.w}, kgv[8] = {kga.x, kga.y, kga.z, kga.w, kgb.x, kgb.y, kgb.z, kgb.w};
                const bool first = (l16 & 4) == 0;
                for (int grp = gw; grp < MT / 4; grp += NGW) {
                    const int row = grp * 4 + gq;
                    const bool lat = row < ML; const int b = lat ? (row >> 11) : ((row - ML) >> 8); const int t = lat ? (row & 2047) : ((row - ML) & 255);
                    const int Tpos = lat ? CTXL + t : t;
                    float cs[8], sn[8];
#pragma unroll
                    for (int k = 0; k < 8; ++k) { cs[k] = 1.f; sn[k] = 0.f; }
                    if (lat) { const int pos = l16 < 8 ? (t >> 6) : (t & 63); const f32x4* tp = (const f32x4*)((const float*)(ws + OFF_ROPE32) + (pos * 32 + 8 * (l16 & 3)) * 2);
#pragma unroll
                        for (int k2 = 0; k2 < 4; ++k2) { const f32x4 tv = tp[k2]; cs[2 * k2] = tv.x; sn[2 * k2] = tv.y; cs[2 * k2 + 1] = tv.z; sn[2 * k2 + 1] = tv.w; } }
                    const bf16_t* zr = Zb + (size_t)row * INE + 2048 + 8 * l16;
                    u32x4 raw[12];
#pragma unroll
                    for (int h = 0; h < 12; ++h) raw[h] = *(const u32x4*)(zr + h * 128);
#pragma unroll
                    for (int h = 0; h < 10; ++h) {
                        float x[8] = {bflo(raw[h].x), bfhi(raw[h].x), bflo(raw[h].y), bfhi(raw[h].y), bflo(raw[h].z), bfhi(raw[h].z), bflo(raw[h].w), bfhi(raw[h].w)};
                        float ss = 0.f;
#pragma unroll
                        for (int k = 0; k < 8; ++k) ss += x[k] * x[k];
                        ss += __shfl_xor(ss, 1); ss += __shfl_xor(ss, 2); ss += __shfl_xor(ss, 4); ss += __shfl_xor(ss, 8);
                        const float rs = 1.0f / sqrtf(ss * (1.0f / 128.0f) + NEPS);
                        float o[8];
#pragma unroll
                        for (int k = 0; k < 8; ++k) { const float y = x[k] * rs * (h < 8 ? qgv[k] : kgv[k]); const float yo = __shfl_xor(y, 4);
                            o[k] = first ? (y * cs[k] - yo * sn[k]) : (yo * sn[k] + y * cs[k]); if (h < 8) o[k] *= QS; }
                        u32x4 w; w.x = cvtpk(o[0], o[1]); w.y = cvtpk(o[2], o[3]); w.z = cvtpk(o[4], o[5]); w.w = cvtpk(o[6], o[7]);
                        if (h < 8) *(u32x4*)(Qb + (size_t)row * 1024 + h * 128 + 8 * l16) = w;
                        else *(u32x4*)(Kb + (size_t)(b * TK + Tpos) * 256 + (h - 8) * 128 + 8 * l16) = w;
                    }
#pragma unroll
                    for (int h = 0; h < 2; ++h) { bf16_t* vp = VTb + (size_t)((b * 2 + h) * 128 + 8 * l16) * TK + Tpos; const u32x4 r = raw[10 + h];
                        vp[0] = (bf16_t)(r.x & 0xffffu); vp[TK] = (bf16_t)(r.x >> 16); vp[2 * TK] = (bf16_t)(r.y & 0xffffu); vp[3 * TK] = (bf16_t)(r.y >> 16);
                        vp[4 * TK] = (bf16_t)(r.z & 0xffffu); vp[5 * TK] = (bf16_t)(r.z >> 16); vp[6 * TK] = (bf16_t)(r.w & 0xffffu); vp[7 * TK] = (bf16_t)(r.w >> 16); }
                }
            }
            if (SUB(1)) {
                const float* dww = args.in[10]; const float* dwb = args.in[11]; const float* lng = args.in[12]; const float* lnb = args.in[13];
                LAS float* red = (LAS float*)lds;
                LAS float* obuf = (LAS float*)(lds + 1024);
                const int c0 = 2 * tid;
                float w0[31], w1[31];
#pragma unroll
                for (int k = 0; k < 31; ++k) { const f32x2 wv = *(const f32x2*)(dww + k * 1024 + c0); w0[k] = wv.x; w1[k] = wv.y; }
                const f32x2 bias = *(const f32x2*)(dwb + c0), lg = *(const f32x2*)(lng + c0), lb = *(const f32x2*)(lnb + c0);
                for (int unit = bid; unit < MT / 16; unit += G) {
                    const int row0 = unit * 16; const bool lat = row0 < ML; const int L = lat ? SEQ : CTXL;
                    const int p0 = lat ? (row0 & 2047) : ((row0 - ML) & 255); const int seq0 = row0 - p0;
                    float a0[16], a1[16];
#pragma unroll
                    for (int o = 0; o < 16; ++o) { a0[o] = bias.x; a1[o] = bias.y; }
                    unsigned ca[8], cgt[8], na[8], ng[8];
#define CONF_LOAD(DA, DG, CH) _Pragma("unroll") for (int k = 0; k < 8; ++k) { const int q = p0 - 15 + 8 * (CH) + k; const int qc = q < 0 ? 0 : (q >= L ? L - 1 : q); \
                        const bf16_t* rowp = Zb + (size_t)(seq0 + qc) * INE; DA[k] = *(const unsigned*)(rowp + (unsigned)c0); DG[k] = *(const unsigned*)(rowp + 1024 + (unsigned)c0); }
                    CONF_LOAD(ca, cgt, 0)
#pragma unroll
                    for (int ch = 0; ch < 6; ++ch) {
                        if (ch < 5) { CONF_LOAD(na, ng, ch + 1) }
                        asm volatile("" ::: "memory");
#pragma unroll
                        for (int k = 0; k < 8; ++k) { const int i = 8 * ch + k; if (i < 46) { const int q = p0 - 15 + i; float u0 = 0.f, u1 = 0.f;
                            if (q >= 0 && q < L) { u0 = bflo(ca[k]) / (1.0f + __expf(-bflo(cgt[k]))); u1 = bfhi(ca[k]) / (1.0f + __expf(-bfhi(cgt[k]))); }
#pragma unroll
                            for (int o = 0; o < 16; ++o) { const int kk = i - o; if (kk >= 0 && kk <= 30) { a0[o] += w0[kk] * u0; a1[o] += w1[kk] * u1; } } } }
#pragma unroll
                        for (int k = 0; k < 8; ++k) { ca[k] = na[k]; cgt[k] = ng[k]; }
                    }
#undef CONF_LOAD
                    float mean[16], rstd[16];
#pragma unroll
                    for (int o = 0; o < 16; ++o) { const float s = wave_sum(a0[o] + a1[o]); if (lane == 0) red[wave * 16 + o] = s; }
                    __syncthreads();
#pragma unroll
                    for (int o = 0; o < 16; ++o) { float s = 0.f;
#pragma unroll
                        for (int w = 0; w < 8; ++w) s += red[w * 16 + o];
                        mean[o] = s * (1.0f / 1024.0f); }
                    __syncthreads();
#pragma unroll
                    for (int o = 0; o < 16; ++o) { const float e0 = a0[o] - mean[o], e1 = a1[o] - mean[o]; const float s = wave_sum(e0 * e0 + e1 * e1); if (lane == 0) red[wave * 16 + o] = s; }
                    __syncthreads();
#pragma unroll
                    for (int o = 0; o < 16; ++o) { float s = 0.f;
#pragma unroll
                        for (int w = 0; w < 8; ++w) s += red[w * 16 + o];
                        rstd[o] = 1.0f / sqrtf(s * (1.0f / 1024.0f) + LNEPS); }
                    __syncthreads();
#pragma unroll
                    for (int o = 0; o < 16; ++o) { const float y0 = (a0[o] - mean[o]) * rstd[o] * lg.x + lb.x, y1 = (a1[o] - mean[o]) * rstd[o] * lg.y + lb.y;
                        *(unsigned*)(MIXb + (size_t)(row0 + o) * D + c0) = pk2(siluf(y0), siluf(y1)); }
                }
            }
        }
        if (EN(4) && ph == 4) {
            for (int it = 0; it < 3; ++it) {
                int unit;
                if (G == 256) { if (it < 2) { const int pair = (bid & 7) * 2 + it, slot = bid >> 3; unit = (pair >> 1) * 64 + ((pair & 1) * 4 + (slot >> 3)) * 8 + (slot & 7); } else unit = bid < 64 ? 512 + bid : -1; }
                else unit = -2;
                if (unit == -1) continue;
                if (unit == -2) { if (it > 0) continue; for (int u = bid; u < 512 + 64; u += G) {
                        if (u < 512) { const int b = u >> 6, h = (u >> 3) & 7, qb = u & 7, hk = h >> 2; const size_t row0 = (size_t)b * SEQ + qb * 256;
                            attn_unit<128>(lds, Qb + row0 * 1024 + h * 128, 1024, Kb + (size_t)b * TK * 256 + hk * 128, 256, VTb + (size_t)((b * 2 + hk) * 128) * TK, TK, MIXb + row0 * D + 1024 + h * 128, D, tid);
                        } else { const int u2 = u - 512, b = u2 >> 3, h = u2 & 7, hk = h >> 2; const size_t row0 = (size_t)ML + b * CTXL;
                            attn_unit<128>(lds, Qb + row0 * 1024 + h * 128, 1024, Kb + (size_t)b * TK * 256 + hk * 128, 256, VTb + (size_t)((b * 2 + hk) * 128) * TK, CTXL, MIXb + row0 * D + 1024 + h * 128, D, tid); }
                        __syncthreads(); }
                    continue; }
                if (unit < 512) { const int b = unit >> 6, h = (unit >> 3) & 7, qb = unit & 7, hk = h >> 2; const size_t row0 = (size_t)b * SEQ + qb * 256;
                    attn_unit<128>(lds, Qb + row0 * 1024 + h * 128, 1024, Kb + (size_t)b * TK * 256 + hk * 128, 256, VTb + (size_t)((b * 2 + hk) * 128) * TK, TK, MIXb + row0 * D + 1024 + h * 128, D, tid);
                } else { const int u2 = unit - 512, b = u2 >> 3, h = u2 & 7, hk = h >> 2; const size_t row0 = (size_t)ML + b * CTXL;
                    attn_unit<128>(lds, Qb + row0 * 1024 + h * 128, 1024, Kb + (size_t)b * TK * 256 + hk * 128, 256, VTb + (size_t)((b * 2 + hk) * 128) * TK, CTXL, MIXb + row0 * D + 1024 + h * 128, D, tid); }
                __syncthreads();
            }
        }
        if (EN(5) && (ph == 5 || ph == 8 || ph == 14 || ph == 17)) {
            const int layer = ph >= 9 ? 1 : 0; const bool down = (ph == 8 || ph == 17); const int Mrows = layer ? ML : MT;
            const bf16_t* A = down ? ACTb : MIXb; const int K = down ? FF : D;
            const bf16_t* Bt = (const bf16_t*)(ws + (ph == 5 ? OFF_WEOUT : ph == 8 ? OFF_WDN0 : ph == 14 ? OFF_WOOUT : OFF_WDN1));
            pg8::Gemm g{A, Bt, Mrows, D, K}; pg8::StaticOrder S; S.init(Mrows, D, G, bid);
            const int nl = ph == 8 ? 1 : layer;
            EpiRes E{ph == 5 ? x_in : XR, ph == 5 ? ctx_in : XR + (size_t)ML * D, XR, MOD + layer * 9 * MODW, down ? 5 : 2,
                     ph == 17 ? (bf16_t*)nullptr : Hb, (ph == 8 ? args.in[6] : args.in[7]) + nl * D, MOD + nl * 9 * MODW + (ph == 8 ? 1 : 4) * D, (float*)(ws + OFF_SS) + (ph == 5 ? 0 : ph == 8 ? 1 : 2) * MT};
            pg8::gemm_phase<EpiRes, pg8::StaticOrder, true, true>(lds, g, S, E);
        }
        if (EN(7) && (ph == 7 || ph == 16)) {
            const int Mrows = ph == 16 ? ML : MT;
            pg8::Gemm g{Hb, (const bf16_t*)(ws + (ph == 7 ? OFF_WGU0 : OFF_WGU1)), Mrows, 2 * FF, D}; pg8::StaticOrder S; S.init(Mrows, 2 * FF, G, bid); EpiSwiGLU E{ACTb, (const float*)(ws + OFF_SS) + (ph == 7 ? 0 : 2) * MT, (const float*)(ws + OFF_SHW) + (ph == 7 ? SHW_F0 : SHW_F1)};
            pg8::gemm_phase<EpiSwiGLU, pg8::StaticOrder, true, true>(lds, g, S, E);
        }
        if (EN(11) && ph == 11) {
            {
                const float* sw = args.in[18]; const float* sb = args.in[19];
                LAS float* tile = (LAS float*)lds;
                u32x4 pre[3];
#define SC_LOAD(U) do { const int cb_ = (U) % 24, tb_ = ((U) / 24) & 31, b_ = (U) / (24 * 32); _Pragma("unroll") for (int p = 0; p < 3; ++p) { const int idx = tid + 512 * p, r = idx >> 4, part = idx & 15, t = tb_ * 64 - 1 + r; \
                        pre[p] = (u32x4){0u, 0u, 0u, 0u}; if (idx < 66 * 16 && t >= 0 && t < SEQ) pre[p] = *(const u32x4*)(Zb + (size_t)(b_ * SEQ + t) * INOP + cb_ * 128 + part * 8); } } while (0)
                if (bid < 8 * 32 * 24) SC_LOAD(bid);
                for (int unit = bid; unit < 8 * 32 * 24; unit += G) {
                    const int cb = unit % 24, tb = (unit / 24) & 31, b = unit / (24 * 32); const int t0 = tb * 64, ch0 = cb * 128;
#pragma unroll
                    for (int p = 0; p < 3; ++p) { const int idx = tid + 512 * p, r = idx >> 4, part = idx & 15; const u32x4 v = pre[p];
                        if (idx < 66 * 16) { LAS float* tp = tile + r * 129 + part * 8;
                            tp[0] = bflo(v.x); tp[1] = bfhi(v.x); tp[2] = bflo(v.y); tp[3] = bfhi(v.y); tp[4] = bflo(v.z); tp[5] = bfhi(v.z); tp[6] = bflo(v.w); tp[7] = bfhi(v.w); } }
                    __syncthreads();
                    if (unit + G < 8 * 32 * 24) SC_LOAD(unit + G);
                    const int cl = ch0 + wave * 16 + (lane & 15); const float w0v = sw[cl], w1v = sw[3072 + cl], w2v = sw[6144 + cl], bv = sb[cl];
#pragma unroll
                    for (int q = 0; q < 16; ++q) { const int ch = wave * 16 + q, cglob = ch0 + ch;
                        const float w0 = __builtin_bit_cast(float, __builtin_amdgcn_readlane(__builtin_bit_cast(int, w0v), q)), w1 = __builtin_bit_cast(float, __builtin_amdgcn_readlane(__builtin_bit_cast(int, w1v), q));
                        const float w2 = __builtin_bit_cast(float, __builtin_amdgcn_readlane(__builtin_bit_cast(int, w2v), q)), bq = __builtin_bit_cast(float, __builtin_amdgcn_readlane(__builtin_bit_cast(int, bv), q));
                        const float v = w0 * tile[lane * 129 + ch] + w1 * tile[(lane + 1) * 129 + ch] + w2 * tile[(lane + 2) * 129 + ch] + bq;
                        HXb[((size_t)cglob * 8 + b) * SEQ + t0 + lane] = (bf16_t)f2bf(v); }
                    __syncthreads();
                }
#undef SC_LOAD
            }
            {
                const float* w4 = args.in[26]; const float* skip = args.in[28];
                LAS float* red = (LAS float*)lds;
                constexpr float DMIN = -3.0701134573253945f, DMAX = -15.350567286626972f;
                for (int unit = bid; unit < 256; unit += G) {
                    const int col = tid & 15, tg = tid >> 4, j = unit * 16 + col; const int dir = j >> 11, n = (j >> 10) & 1, c = j & 1023;
                    float w4r[64];
#pragma unroll
                    for (int m = 0; m < 64; ++m) w4r[m] = w4[m * 4096 + j];
                    const float delta = fabsf(DMIN + (float)c * ((DMAX - DMIN) / 1023.0f));
                    float asum = 0.f;
                    float* fp = FILT + (size_t)(n * 1024 + c) * 4096;
                    LAS float* hst = (LAS float*)(lds + 4096);
                    f32x4 hpre[8];
#pragma unroll
                    for (int p = 0; p < 8; ++p) hpre[p] = *(const f32x4*)(H3 + (tid + 512 * p) * 4);
                    const float r32 = expf(-(32.0f / (float)(SEQ - 1)) * delta);
                    for (int chk = 0; chk < 8; ++chk) {
                        __syncthreads();
#pragma unroll
                        for (int p = 0; p < 8; ++p) *(LAS f32x4*)(hst + (tid + 512 * p) * 4) = hpre[p];
                        __syncthreads();
                        if (chk < 7) {
#pragma unroll
                            for (int p = 0; p < 8; ++p) hpre[p] = *(const f32x4*)(H3 + (chk + 1) * 256 * 64 + (tid + 512 * p) * 4); }
                        float dec = expf(-((float)(chk * 256 + tg) / (float)(SEQ - 1)) * delta);
#pragma unroll 2
                        for (int i = 0; i < 8; ++i) { const int tl = tg + 32 * i, t = chk * 256 + tl; const LAS f32x4* hp = (const LAS f32x4*)(hst + tl * 64); float dot = 0.f;
#pragma unroll
                            for (int m4 = 0; m4 < 16; ++m4) { const f32x4 hv = hp[m4]; dot += hv.x * w4r[4 * m4] + hv.y * w4r[4 * m4 + 1] + hv.z * w4r[4 * m4 + 2] + hv.w * w4r[4 * m4 + 3]; }
                            const float v = dot * dec; dec *= r32; asum += fabsf(v);
                            if (dir == 0) fp[2048 + t] = v; else if (t >= 1) fp[2048 - t] = v; }
                    }
                    __syncthreads();
                    red[tg * 16 + col] = asum;
                    __syncthreads();
                    float tot = 0.f;
                    for (int q = 0; q < 32; ++q) tot += red[q * 16 + col];
                    const float nrm = 1.0f / (tot + 1e-6f);
#pragma unroll 1
                    for (int i0 = 0; i0 < 64; i0 += 16) { float vv[16];
#pragma unroll
                        for (int i = 0; i < 16; ++i) { const int t = tg + 32 * (i0 + i); const int idx = dir == 0 ? 2048 + t : (t >= 1 ? 2048 - t : 2048); vv[i] = fp[idx]; }
#pragma unroll
                        for (int i = 0; i < 16; ++i) { const int t = tg + 32 * (i0 + i); float v = vv[i] * nrm;
                            if (dir == 0) { if (t == 0) v += skip[n * 1024 + c]; fp[2048 + t] = v; }
                            else { if (t >= 1) fp[2048 - t] = v; else fp[0] = 0.f; } } }
                }
            }
            {
                const float* qng = args.in[29]; const float* kvg = args.in[30];
                const int jr = lane & 15, sub = (lane >> 4) & 1, e0 = sub * 32 + jr, e1 = e0 + 16;
                const float inv = exp2f(-(float)jr * (LOG2_THETA / 16.0f));
                for (int row = gw; row < MT; row += NGW) {
                    const bool lat = row < ML; const int b = lat ? (row >> 11) : ((row - ML) >> 8); const int t = lat ? (row & 2047) : ((row - ML) & 255);
                    const int Tpos = lat ? CTXL + t : t;
                    const bf16_t* zkv = lat ? Zb + (size_t)row * INOP + 3584 : ZCb + (size_t)(row - ML) * 512;
                    if (lat) { const u32x4 v = *(const u32x4*)(Zb + (size_t)row * INOP + 3072 + lane * 8);
                        float f[8] = {bflo(v.x), bfhi(v.x), bflo(v.y), bfhi(v.y), bflo(v.z), bfhi(v.z), bflo(v.w), bfhi(v.w)}; float ss = 0.f;
#pragma unroll
                        for (int k = 0; k < 8; ++k) ss += f[k] * f[k];
                        const float rs = 1.0f / sqrtf(wave_sum(ss) * (1.0f / 512.0f) + NEPS);
                        const f32x4 g0 = *(const f32x4*)(qng + lane * 8), g1 = *(const f32x4*)(qng + lane * 8 + 4);
                        u32x4 w; w.x = pk2(f[0] * rs * g0.x, f[1] * rs * g0.y); w.y = pk2(f[2] * rs * g0.z, f[3] * rs * g0.w); w.z = pk2(f[4] * rs * g1.x, f[5] * rs * g1.y); w.w = pk2(f[6] * rs * g1.z, f[7] * rs * g1.w);
                        *(u32x4*)(QNb + (size_t)row * 512 + lane * 8) = w; }
                    { const u32x2 v = *(const u32x2*)(zkv + lane * 4); const float f0 = bflo(v.x), f1 = bfhi(v.x), f2 = bflo(v.y), f3 = bfhi(v.y);
                        const float rs = 1.0f / sqrtf(wave_sum(f0 * f0 + f1 * f1 + f2 * f2 + f3 * f3) * (1.0f / 256.0f) + NEPS);
                        const f32x4 g = *(const f32x4*)(kvg + lane * 4);
                        u32x2 w; w.x = pk2(f0 * rs * g.x, f1 * rs * g.y); w.y = pk2(f2 * rs * g.z, f3 * rs * g.w);
                        *(u32x2*)(CKVb + (size_t)row * 256 + lane * 4) = w; }
                    if (lane < 32) { float x0 = bf2f(zkv[256 + e0]), x1 = bf2f(zkv[256 + e1]);
                        if (lat) { const float pos = sub ? (float)(t & 63) : (float)(t >> 6); float sn, cs; { const float ang = pos * inv; sn = sinf(ang); cs = cosf(ang); } const float y0 = x0 * cs - x1 * sn, y1 = x0 * sn + x1 * cs; x0 = y0; x1 = y1; }
                        const bf16_t r0 = (bf16_t)f2bf(x0), r1 = (bf16_t)f2bf(x1); bf16_t* kp = Kb + (size_t)(b * TK + Tpos) * 1536 + 128;
#pragma unroll
                        for (int h = 0; h < 8; ++h) { kp[h * 192 + e0] = r0; kp[h * 192 + e1] = r1; } }
                }
            }
        }
        if (EN(12) && ph == 12) {
            if (SUB(2)) {
                constexpr int FL = 4240, UL = 2704;
                LAS unsigned char* Fc = lds;
                LAS unsigned char* Ul = lds + 8 * FL * 2;
                const int i16 = lane & 15, kg = lane >> 4, sg = i16 >> 3, bb = i16 & 7;
                const int pq = (wave & 1) + 32 * (wave >> 1);
                const int abase = ((i16 & 7) * FL + 8 * kg - (i16 & 8) + 2048 - 16 * pq) * 2;
                const int bbase = (bb * UL + 264 * sg) * 2;
                { const int b = tid >> 6, ch = tid & 63, pos = ch < 32 ? 8 * ch : 2376 + 8 * (ch - 32);
                  *(LAS u32x4*)(Ul + (b * UL + pos) * 2) = (u32x4){0u, 0u, 0u, 0u}; }
                for (int c = bid; c < 1024; c += G) {
                    { const bf16_t* vp = HXb + ((size_t)(2 * 1024 + c) * 8) * SEQ;
#pragma unroll
                      for (int p = 0; p < 4; ++p) { const int idx = tid + 512 * p, b = idx >> 8, part = idx & 255; const int sp = 256 + 8 * part;
                          *(LAS u32x4*)(Ul + (b * UL + sp + 8 * (sp >> 8)) * 2) = *(const u32x4*)(vp + (size_t)b * SEQ + part * 8); } }
#pragma unroll 1
                    for (int n = 0; n < 2; ++n) {
                        { const float* fp = FILT + (size_t)(n * 1024 + c) * 4096 + 2048;
#pragma unroll
                          for (int k = 0; k < 9; ++k) { const int g0 = tid + 512 * k, g = g0 < 8 * (FL / 8) ? g0 : 0; const int m = g & 7, Y0 = 8 * (g >> 3); const int d0 = 2048 + m - Y0;
                              float v[8];
#pragma unroll
                              for (int j = 0; j < 8; ++j) { const int d = d0 - j, dc = d < -2047 ? -2047 : (d > 2047 ? 2047 : d); const float x = fp[dc]; v[j] = (d == dc) ? x : 0.f; }
                              u32x4 w; w.x = cvtpk(v[0], v[1]); w.y = cvtpk(v[2], v[3]); w.z = cvtpk(v[4], v[5]); w.w = cvtpk(v[6], v[7]);
                              if (g0 < 8 * (FL / 8)) *(LAS u32x4*)(Fc + (m * FL + Y0) * 2) = w; } }
                        const bf16_t* gp = HXb + ((size_t)(n * 1024 + c) * 8 + bb) * SEQ;
                        u32x2 gv[8];
#pragma unroll
                        for (int r = 0; r < 8; ++r) gv[r] = *(const u32x2*)(gp + 16 * ((wave & 1) + 2 * (16 * (wave >> 1) + 8 * sg + r)) + 4 * kg);
                        __syncthreads();
                        pg8::f32x4 acc[8];
#pragma unroll
                        for (int r = 0; r < 8; ++r) acc[r] = (pg8::f32x4){0.f, 0.f, 0.f, 0.f};
                        bf16x8 aw[9];
#pragma unroll
                        for (int r = 0; r < 8; ++r) aw[(r + 8) % 9] = *(const LAS bf16x8*)(Fc + abase + 64 * (-8 - r));
                        bf16x8 bcur = *(const LAS bf16x8*)(Ul + bbase + (8 * kg) * 2);
#pragma unroll 1
                        for (int it = 0; it < 8; ++it) {
#pragma unroll
                            for (int u = 0; u < 9; ++u) {
                                const int J = -8 + 9 * it + u;
                                aw[(16 - u) % 9] = *(const LAS bf16x8*)(Fc + abase + 64 * (J + 1));
                                const int sbn = 288 * it + 32 * (u + 1) + 8 * kg;
                                const bf16x8 bnext = *(const LAS bf16x8*)(Ul + bbase + (sbn + 8 * (sbn >> 8)) * 2);
#pragma unroll
                                for (int r = 0; r < 8; ++r) acc[r] = __builtin_amdgcn_mfma_f32_16x16x32_bf16(aw[(r + 8 - u) % 9], bcur, acc[r], 0, 0, 0);
                                bcur = bnext;
                            }
                        }
                        __syncthreads();
#pragma unroll
                        for (int r = 0; r < 8; ++r) { const int t0 = 16 * ((wave & 1) + 2 * (16 * (wave >> 1) + 8 * sg + r)) + 4 * kg;
                            u32x2 w; w.x = cvtpk(bflo(gv[r].x) * acc[r][0], bfhi(gv[r].x) * acc[r][1]); w.y = cvtpk(bflo(gv[r].y) * acc[r][2], bfhi(gv[r].y) * acc[r][3]);
                            if (n == 0) { const int sp = 256 + t0; *(LAS u32x2*)(Ul + (bb * UL + sp + 8 * (sp >> 8)) * 2) = w; }
                            else *(u32x2*)(Zb + ((size_t)c * 8 + bb) * SEQ + t0) = w; }
                    }
                }
                __syncthreads();
            }
            const int kop = args.ph_hi > 1000 ? 128 : 256;
            if (SUB(3)) { pg8::Gemm g{QNb, (const bf16_t*)(ws + OFF_WUQ), ML, 1536, 2 * kop}; pg8::StaticOrder S; S.init(ML, 1536, G, bid); EpiRopeQ E{Qb, 0.07216878364870323f * LOG2E, (const float*)(ws + OFF_ROPE16)};
              pg8::gemm_phase<EpiRopeQ, pg8::StaticOrder, true, true>(lds, g, S, E); }
            if (SUB(4)) { pg8::Gemm g{CKVb, (const bf16_t*)(ws + OFF_WUKV), MT, 1024, kop}; pg8::StaticOrder S; S.init(MT, 1024, G, bid); EpiKnope E{Kb};
              pg8::gemm_phase<EpiKnope, pg8::StaticOrder, true, true>(lds, g, S, E); }
            if (SUB(5)) { pg8::Gemm g{(const bf16_t*)(ws + OFF_WUKV) + (size_t)1024 * 256, CKVb, 1024, MT, kop}; pg8::StaticOrder S; S.init(1024, MT, G, bid); EpiVt E{VTb};
              pg8::gemm_phase<EpiVt, pg8::StaticOrder, true, true>(lds, g, S, E); }
        }
        if (EN(13) && ph == 13) {
            for (int u0 = bid; u0 < 512; u0 += G) {
                int unit = u0;
                if (G == 256) { const int it = u0 >> 8, slot = bid >> 3; unit = (((bid & 7) * 2 + it) * 4 + (slot >> 3)) * 8 + (slot & 7); }
                const int b = unit >> 6, h = (unit >> 3) & 7, qb = unit & 7; const size_t row0 = (size_t)b * SEQ + qb * 256;
                attn_unit_simple<192>(lds, Qb + row0 * 1536 + h * 192, 1536, Kb + (size_t)b * TK * 1536 + h * 192, 1536, VTb + (size_t)((b * 8 + h) * 128) * TK, TK, MIXb + row0 * D + 1024 + h * 128, D, tid);
                __syncthreads();
            }
            {
                LAS bf16_t* tile = (LAS bf16_t*)lds;
                const bf16_t* yp = Zb;
                for (int unit = bid; unit < 8 * 32 * 8; unit += G) {
                    const int cb = unit & 7, tb = (unit >> 3) & 31, b = unit >> 8; const int t0 = tb * 64, c0 = cb * 128;
#pragma unroll
                    for (int p = 0; p < 2; ++p) { const int idx = tid + 512 * p, cc = idx >> 3, part = idx & 7; const u32x4 v = *(const u32x4*)(yp + ((size_t)(c0 + cc) * 8 + b) * SEQ + t0 + part * 8);
                        LAS unsigned* tp = (LAS unsigned*)(tile + cc * 66 + part * 8); tp[0] = v.x; tp[1] = v.y; tp[2] = v.z; tp[3] = v.w; }
                    __syncthreads();
#pragma unroll
                    for (int p = 0; p < 2; ++p) { const int idx = tid + 512 * p, t = idx >> 4, part = idx & 15; const LAS bf16_t* sp = tile + (part * 8) * 66 + t;
                        u32x4 w; w.x = (unsigned)sp[0] | ((unsigned)sp[66] << 16); w.y = (unsigned)sp[2 * 66] | ((unsigned)sp[3 * 66] << 16); w.z = (unsigned)sp[4 * 66] | ((unsigned)sp[5 * 66] << 16); w.w = (unsigned)sp[6 * 66] | ((unsigned)sp[7 * 66] << 16);
                        *(u32x4*)(MIXb + (size_t)(b * SEQ + t0 + t) * D + c0 + part * 8) = w; }
                    __syncthreads();
                }
            }
        }
        if (EN(18) && ph == 18) {
            const float* g = args.in[36];
            f32x4 v[8], nv[8];
            if (gw < ML) {
#pragma unroll
                for (int j = 0; j < 8; ++j) v[j] = ((const f32x4*)(XR + (size_t)gw * D))[lane + 64 * j]; }
            for (int row = gw; row < ML; row += NGW) {
                const int nrow = row + NGW;
                if (nrow < ML) {
#pragma unroll
                    for (int j = 0; j < 8; ++j) nv[j] = ((const f32x4*)(XR + (size_t)nrow * D))[lane + 64 * j]; }
                float ss = 0.f;
#pragma unroll
                for (int j = 0; j < 8; ++j) ss += (v[j].x * v[j].x + v[j].y * v[j].y) + (v[j].z * v[j].z + v[j].w * v[j].w);
                const float rs = 1.0f / sqrtf(wave_sum(ss) * (1.0f / D) + NEPS);
                f32x4* op = (f32x4*)(args.out + (size_t)row * D);
#pragma unroll
                for (int j = 0; j < 8; ++j) { const f32x4 gg = ((const f32x4*)g)[lane + 64 * j]; op[lane + 64 * j] = v[j] * rs * gg; }
#pragma unroll
                for (int j = 0; j < 8; ++j) v[j] = nv[j];
            }
        }
}

#ifndef DUPMASK
#define DUPMASK 0u
#endif
#ifndef SYNCDUP
#define SYNCDUP 0
#endif
#define GRID_BAR(k) do { if ((k) == 0) grid.sync(); else xcd_barrier(bar); } while (0)
#define RUN_PHASE(k) do { if ((k) != 6 && (k) != 9 && (k) != 15 && args.ph_lo <= (k) && (k) < args.ph_hi) { run_phase<(k)>(args, lds); \
    if (((DUPMASK) >> (k)) & 1u) { GRID_BAR(k); run_phase<(k)>(args, lds); } \
    if ((k) + 1 < args.ph_hi) { GRID_BAR(k); if (SYNCDUP) GRID_BAR(k); } } } while (0)
__global__ void __launch_bounds__(512, 2) mega_fwd(Args args) {
    extern __shared__ __attribute__((aligned(16))) unsigned char lds_raw[];
    LAS unsigned char* lds = (LAS unsigned char*)lds_raw;
    cg::grid_group grid = cg::this_grid();
    volatile LAS unsigned* bst = (volatile LAS unsigned*)(lds + LDS_BYTES - 64);
    if (threadIdx.x < 2) bst[threadIdx.x] = 0u;
    __syncthreads();
    const XcdBarrier bar = xcd_barrier_post((unsigned*)args.ws, bst);
    RUN_PHASE(0); RUN_PHASE(1); RUN_PHASE(2); RUN_PHASE(3); RUN_PHASE(4); RUN_PHASE(5); RUN_PHASE(6); RUN_PHASE(7); RUN_PHASE(8); RUN_PHASE(9);
    RUN_PHASE(10); RUN_PHASE(11); RUN_PHASE(12); RUN_PHASE(13); RUN_PHASE(14); RUN_PHASE(15); RUN_PHASE(16); RUN_PHASE(17); RUN_PHASE(18);
}
}

extern "C" void kernel_launch(void* const* d_in, const int* in_sizes, int n_in, void* d_out, int out_size, void* d_ws, size_t ws_size, hipStream_t stream) {
    static int grid = 0;
    if (grid == 0) {
        if (n_in != 37 || ws_size < mk::WS_END) { fprintf(stderr, "kernel_launch: unexpected n_in %d / ws_size %zu\n", n_in, ws_size); grid = -1; return; }
        int dev = 0, cus = 0, per_cu = 0;
        hipGetDevice(&dev); hipDeviceGetAttribute(&cus, hipDeviceAttributeMultiprocessorCount, dev);
        hipFuncSetAttribute((const void*)mk::mega_fwd, hipFuncAttributeMaxDynamicSharedMemorySize, mk::LDS_BYTES);
        hipOccupancyMaxActiveBlocksPerMultiprocessor(&per_cu, (const void*)mk::mega_fwd, 512, mk::LDS_BYTES);
        if (per_cu < 1) { fprintf(stderr, "kernel_launch: occupancy query says %d\n", per_cu); per_cu = 1; }
        (void)hipGetLastError();
        grid = cus * 1;
    }
    if (grid < 0) return;
    if (hipMemsetAsync(d_ws, 0, 16384, stream) != hipSuccess) { fprintf(stderr, "kernel_launch: memset failed\n"); return; }
    mk::Args a{};
    for (int i = 0; i < 37; ++i) a.in[i] = (const float*)d_in[i];
    a.out = (float*)d_out; a.ws = (unsigned char*)d_ws; a.ph_lo = 0; a.ph_hi = mk::NPHASE;
    void* kargs[] = {&a};
    hipError_t e = hipLaunchCooperativeKernel((const void*)mk::mega_fwd, dim3(grid), dim3(512), kargs, mk::LDS_BYTES, stream);
    if (e != hipSuccess) fprintf(stderr, "cooperative launch failed: %s (grid %d)\n", hipGetErrorString(e), grid);
}
```

```cpp
#include <hip/hip_runtime.h>
#include <hip/hip_cooperative_groups.h>
#include <cstdio>
#include <cstdint>
#include <cmath>
namespace cg = cooperative_groups;
#define DUPMASK 0u
#define SYNCDUP 0
namespace pg8 {
#define PG8_LAS __attribute__((address_space(3)))
typedef unsigned short bf16_t;
typedef short bf16x8 __attribute__((ext_vector_type(8)));
typedef float f32x4 __attribute__((ext_vector_type(4)));
typedef unsigned u32x4 __attribute__((ext_vector_type(4)));
constexpr int BM = 256, BK = 64, HALF = 128, HTB = HALF * BK * 2  , STAGE_BYTES = 8 * HTB, NXCD = 8, WGM = 4;

__host__ __device__ __forceinline__ int lds_byte(int r, int c) { const int st = (r >> 4) * 2 + (c >> 5), rr = r & 15, cc = c & 31, ob = rr * 64 + cc * 2; return st * 1024 + (ob ^ (((ob >> 9) & 1) << 5)); }
__host__ __device__ __forceinline__ void stage_rc(int b, int& R, int& C) { const int st = b / 1024, sb = b % 1024, swz = sb ^ (((sb >> 9) & 1) << 5); R = (st >> 1) * 16 + swz / 64; C = (st & 1) * 32 + (swz % 64) / 2; }
__host__ __device__ __forceinline__ int perm32(int rho) { const int n = rho >> 4, i = rho & 15; return 8 * (i >> 2) + 4 * n + (i & 3); }

struct Unit { int pm, pn; };
struct Gemm { const bf16_t* A; const bf16_t* Bt; int M, N, K; };

struct StaticOrder {
    int nM, nN, nwg, G, c;
    __host__ __device__ void init(int M, int N, int G_, int c_) { nM = M / BM; nN = N / BM; nwg = nM * nN; G = G_; c = c_; }
    __host__ __device__ bool next(int i, Unit& u) const {
        const long L = (long)i * G + c; if (L >= nwg) return false;
        int wgid = (int)L; { const int q = nwg / NXCD, r = nwg % NXCD, xcd = wgid % NXCD, off = wgid / NXCD; wgid = (xcd < r ? xcd * (q + 1) : r * (q + 1) + (xcd - r) * q) + off; }
        const int nig = WGM * nN, gid = wgid / nig, fm = gid * WGM, gsz = (nM - fm) < WGM ? (nM - fm) : WGM;
        u.pm = fm + ((wgid % nig) % gsz); u.pn = (wgid % nig) / gsz; return true;
    }
    __device__ __forceinline__ void a_ready(const Unit&) const {}
    __device__ __forceinline__ void done(const Unit&) const {}
};

__device__ __forceinline__ unsigned cvt_pk_bf16(float lo, float hi) { unsigned r; asm volatile("v_cvt_pk_bf16_f32 %0, %1, %2" : "=v"(r) : "v"(lo), "v"(hi)); return r; }
template <class Epi, class Sched, bool ALIGN_EPI = false, bool SP2 = false>
__device__ __forceinline__ void gemm_phase(PG8_LAS unsigned char* lds, const Gemm g, const Sched& S, const Epi& E) {
    const int tid = threadIdx.x, wid = __builtin_amdgcn_readfirstlane(tid >> 6), lane = tid & 63, wr = wid >> 2, wc = wid & 3, fr = lane & 15, fq = lane >> 4;
    const int K = g.K, nt = K / BK;
    unsigned voffA[2], voffB[2];
#pragma unroll
    for (int i = 0; i < 2; ++i) { int R, C; stage_rc(tid * 16 + i * 8192, R, C); const int Rb = Epi::PERM ? ((R & ~31) + perm32(R & 31)) : R;
        voffA[i] = (unsigned)(R * K + C) * 2u; voffB[i] = (unsigned)(Rb * K + C) * 2u; }
    const size_t kstep = (size_t)(BK * 2);
    const size_t hstep = (size_t)HALF * K * 2;
    const size_t tstep = 2 * hstep;
    const unsigned ldsw = (unsigned)wid * 1024u;
    const int aoff = lds_byte(wr * 64 + fr, fq * 8), boff = lds_byte(wc * 32 + fr, fq * 8);
#define PG8_SA(b, h) (((b) * 2 + (h)) * HTB)
#define PG8_SB(b, h) ((4 + (b) * 2 + (h)) * HTB)
#define PG8_STAGE(bufoff, gbase, voff) do { _Pragma("unroll") for (int _i = 0; _i < 2; ++_i) \
        __builtin_amdgcn_global_load_lds((const unsigned*)((const char*)(gbase) + (voff)[_i]), (PG8_LAS unsigned*)(lds + (bufoff) + ldsw + _i * 8192), 16, 0, 0); } while (0)
#define PG8_LDA(dst, b, h) do { _Pragma("unroll") for (int m = 0; m < 4; ++m) _Pragma("unroll") for (int k = 0; k < 2; ++k) dst[m][k] = *(const PG8_LAS bf16x8*)(lds + PG8_SA(b, h) + aoff + m * 2048 + k * 1024); } while (0)
#define PG8_LDB(dst, b, h) do { _Pragma("unroll") for (int n = 0; n < 2; ++n) _Pragma("unroll") for (int k = 0; k < 2; ++k) dst[n][k] = *(const PG8_LAS bf16x8*)(lds + PG8_SB(b, h) + boff + n * 2048 + k * 1024); } while (0)
#define PG8_MMA(ai, bj, At, Bt) do { __builtin_amdgcn_s_setprio(1); _Pragma("unroll") for (int m = 0; m < 4; ++m) _Pragma("unroll") for (int n = 0; n < 2; ++n) _Pragma("unroll") for (int k = 0; k < 2; ++k) \
        acc[ai][bj][m][n] = __builtin_amdgcn_mfma_f32_16x16x32_bf16(Bt[n][k], At[m][k], acc[ai][bj][m][n], 0, 0, 0); __builtin_amdgcn_s_setprio(0); } while (0)
#define PG8_WAIT_V(n) asm volatile("s_waitcnt vmcnt(" #n ")" ::: "memory")
#define PG8_WAIT_L(n) asm volatile("s_waitcnt lgkmcnt(" #n ")" ::: "memory")
#define PG8_BAR __builtin_amdgcn_s_barrier()
#define PG8_SCHED __builtin_amdgcn_sched_barrier(0)
    Unit cur, nxt; int ui = 0;
    if (!S.next(0, cur)) return;
    f32x4 acc[2][2][4][2];
#pragma unroll
    for (int a = 0; a < 2; ++a)
#pragma unroll
        for (int b = 0; b < 2; ++b)
#pragma unroll
            for (int m = 0; m < 4; ++m)
#pragma unroll
                for (int n = 0; n < 2; ++n) acc[a][b][m][n] = (f32x4){0.f, 0.f, 0.f, 0.f};
    bf16x8 At[4][2], B0[2][2], B1[2][2];
    const char* cA = (const char*)g.A + (size_t)cur.pm * tstep; const char* cB = (const char*)g.Bt + (size_t)cur.pn * tstep;
    S.a_ready(cur);
    if constexpr (SP2) {
        PG8_STAGE(PG8_SB(0, 0), cB, voffB); PG8_STAGE(PG8_SB(0, 1), cB + hstep, voffB); PG8_STAGE(PG8_SA(0, 0), cA, voffA); PG8_STAGE(PG8_SA(0, 1), cA + hstep, voffA);
        if (wr == 1) PG8_BAR;
        PG8_WAIT_V(2); PG8_BAR;
        PG8_STAGE(PG8_SB(1, 0), cB + kstep, voffB); PG8_STAGE(PG8_SA(1, 0), cA + kstep, voffA); PG8_STAGE(PG8_SB(1, 1), cB + hstep + kstep, voffB);
        PG8_WAIT_V(6); PG8_BAR;
    } else {
        PG8_STAGE(PG8_SB(0, 0), cB, voffB); PG8_STAGE(PG8_SA(0, 0), cA, voffA); PG8_STAGE(PG8_SB(0, 1), cB + hstep, voffB); PG8_STAGE(PG8_SA(0, 1), cA + hstep, voffA);
        if (wr == 1) PG8_BAR;
        PG8_WAIT_V(4); PG8_BAR;
        PG8_STAGE(PG8_SB(1, 0), cB + kstep, voffB); PG8_STAGE(PG8_SA(1, 0), cA + kstep, voffA); PG8_STAGE(PG8_SB(1, 1), cB + hstep + kstep, voffB);
        PG8_WAIT_V(6); PG8_BAR;
    }
    for (;;) {
        const bool has_next = S.next(ui + 1, nxt);
        const char* nA = has_next ? (const char*)g.A + (size_t)nxt.pm * tstep : cA; const char* nB = has_next ? (const char*)g.Bt + (size_t)nxt.pn * tstep : cB;
        for (int t = 0; t < nt; t += 2) {
            const bool last = (t == nt - 2);
            const char* a1 = cA + (size_t)(t + 1) * kstep;
            const char* a2 = last ? nA : cA + (size_t)(t + 2) * kstep; const char* b2 = last ? nB : cB + (size_t)(t + 2) * kstep;
            const char* a3 = a2 + kstep; const char* b3 = b2 + kstep;
            if (last && has_next) S.a_ready(nxt);
            if constexpr (SP2) {
            PG8_LDB(B0, 0, 0); PG8_LDB(B1, 0, 1); PG8_SCHED; PG8_LDA(At, 0, 0); PG8_STAGE(PG8_SA(1, 1), a1 + hstep, voffA);
            PG8_WAIT_V(8); PG8_WAIT_L(0); PG8_BAR; PG8_MMA(0, 0, At, B0); PG8_MMA(0, 1, At, B1); PG8_BAR; PG8_SCHED;
            PG8_LDA(At, 0, 1); PG8_STAGE(PG8_SB(0, 0), b2, voffB); PG8_STAGE(PG8_SB(0, 1), b2 + hstep, voffB); PG8_STAGE(PG8_SA(0, 0), a2, voffA);
            PG8_WAIT_V(8); PG8_WAIT_L(0); PG8_BAR; PG8_MMA(1, 0, At, B0); PG8_MMA(1, 1, At, B1); PG8_BAR; PG8_SCHED;
            PG8_LDB(B0, 1, 0); PG8_LDB(B1, 1, 1); PG8_SCHED; PG8_LDA(At, 1, 0); PG8_STAGE(PG8_SA(0, 1), a2 + hstep, voffA);
            PG8_WAIT_V(8); PG8_WAIT_L(0); PG8_BAR; PG8_MMA(0, 0, At, B0); PG8_MMA(0, 1, At, B1); PG8_BAR; PG8_SCHED;
            PG8_LDA(At, 1, 1); PG8_STAGE(PG8_SB(1, 0), b3, voffB); PG8_STAGE(PG8_SB(1, 1), b3 + hstep, voffB); PG8_STAGE(PG8_SA(1, 0), a3, voffA);
            PG8_WAIT_V(8); PG8_WAIT_L(0); PG8_BAR; PG8_MMA(1, 0, At, B0); PG8_MMA(1, 1, At, B1); PG8_BAR; PG8_SCHED;
            } else {
            PG8_LDB(B0, 0, 0); PG8_SCHED; PG8_LDA(At, 0, 0); PG8_STAGE(PG8_SA(1, 1), a1 + hstep, voffA);
            PG8_WAIT_L(8); PG8_BAR; PG8_WAIT_L(0); PG8_MMA(0, 0, At, B0); PG8_BAR; PG8_SCHED;
            PG8_LDB(B1, 0, 1); PG8_STAGE(PG8_SB(0, 0), b2, voffB);
            PG8_BAR; PG8_WAIT_L(0); PG8_MMA(0, 1, At, B1); PG8_BAR;
            PG8_LDA(At, 0, 1); PG8_STAGE(PG8_SA(0, 0), a2, voffA);
            PG8_BAR; PG8_WAIT_L(0); PG8_MMA(1, 0, At, B0); PG8_BAR; PG8_SCHED;
            PG8_STAGE(PG8_SB(0, 1), b2 + hstep, voffB);
            PG8_WAIT_V(6); PG8_BAR; PG8_MMA(1, 1, At, B1); PG8_BAR;
            PG8_LDB(B0, 1, 0); PG8_SCHED; PG8_LDA(At, 1, 0); PG8_STAGE(PG8_SA(0, 1), a2 + hstep, voffA);
            PG8_WAIT_L(8); PG8_BAR; PG8_WAIT_L(0); PG8_MMA(0, 0, At, B0); PG8_BAR; PG8_SCHED;
            PG8_LDB(B1, 1, 1); PG8_STAGE(PG8_SB(1, 0), b3, voffB);
            PG8_BAR; PG8_WAIT_L(0); PG8_MMA(0, 1, At, B1); PG8_BAR;
            PG8_LDA(At, 1, 1); PG8_STAGE(PG8_SA(1, 0), a3, voffA);
            PG8_BAR; PG8_WAIT_L(0); PG8_MMA(1, 0, At, B0); PG8_BAR; PG8_SCHED;
            PG8_STAGE(PG8_SB(1, 1), b3 + hstep, voffB);
            PG8_WAIT_V(6); PG8_BAR; PG8_MMA(1, 1, At, B1); PG8_BAR;
            }
        }
        if constexpr (ALIGN_EPI) { if (wr == 0) PG8_BAR; }
        if constexpr (!Epi::AFTER_DRAIN) { E(acc, cur, wr, wc, fr, fq); S.done(cur); }
        if (!has_next) break;
#pragma unroll
        for (int a = 0; a < 2; ++a)
#pragma unroll
            for (int b = 0; b < 2; ++b)
#pragma unroll
                for (int m = 0; m < 4; ++m)
#pragma unroll
                    for (int n = 0; n < 2; ++n) acc[a][b][m][n] = (f32x4){0.f, 0.f, 0.f, 0.f};
        cur = nxt; cA = nA; cB = nB; ++ui;
        if constexpr (ALIGN_EPI) { if (wr == 1) PG8_BAR; }
    }
    PG8_WAIT_V(0);
    if constexpr (!ALIGN_EPI) { if (wr == 0) PG8_BAR; }
    PG8_BAR;
    if constexpr (Epi::AFTER_DRAIN) { E.fused(acc, cur, wr, wc, fr, fq, lds, wid, lane); S.done(cur); }
#undef PG8_SA
#undef PG8_SB
#undef PG8_STAGE
#undef PG8_LDA
#undef PG8_LDB
#undef PG8_MMA
#undef PG8_WAIT_V
#undef PG8_WAIT_L
#undef PG8_BAR
#undef PG8_SCHED
}
}

namespace mk {
#define LAS __attribute__((address_space(3)))
typedef unsigned short bf16_t;
typedef float f32x4 __attribute__((ext_vector_type(4)));
typedef float f32x2 __attribute__((ext_vector_type(2)));
typedef float f32x16 __attribute__((ext_vector_type(16)));
typedef short bf16x8 __attribute__((ext_vector_type(8)));
typedef unsigned u32x4 __attribute__((ext_vector_type(4)));
typedef unsigned u32x2 __attribute__((ext_vector_type(2)));

constexpr int D = 2048, NB = 8, SEQ = 2048, CTXL = 256;
constexpr int ML = NB * SEQ, MC = NB * CTXL, MT = ML + MC, TK = SEQ + CTXL;
constexpr int FF = 5632, INE = 3584, INO = 3904, INOP = 4096, MODW = 6 * D;
constexpr float NEPS = 1e-6f, LNEPS = 1e-5f;
constexpr float LOG2E = 1.4426950408889634f;
constexpr float LOG2_THETA = 13.287712379549449f;

constexpr size_t MiB = 1u << 20;
constexpr size_t OFF_MOD = 1 * MiB, OFF_H3 = 2 * MiB, OFF_ROPE16 = 2 * MiB + 768 * 1024, OFF_ROPE32 = 2 * MiB + 768 * 1024 + 16384;
constexpr size_t OFF_WOIN = 3 * MiB, OFF_WOOUT = 19 * MiB, OFF_WUQ = 27 * MiB, OFF_WUKV = 29 * MiB, OFF_WGU1 = 30 * MiB, OFF_WDN1 = 74 * MiB;
constexpr size_t OFF_XR = 96 * MiB;
constexpr size_t OFF_WEIN = 240 * MiB, OFF_WEOUT = 254 * MiB, OFF_WGU0 = 262 * MiB, OFF_WDN0 = 306 * MiB;
constexpr size_t OFF_H = 328 * MiB, OFF_Z = 400 * MiB, OFF_ZC = 528 * MiB, OFF_MIX = 530 * MiB;
constexpr size_t OFF_Q = 602 * MiB, OFF_K = 650 * MiB, OFF_VT = 704 * MiB, WS_END = 740 * MiB;
constexpr size_t OFF_SHW = 32 * 1024, OFF_SS = 2 * MiB + 512 * 1024;
constexpr int SHW_F0 = 0, SHW_F1 = 9 * 2 * FF, SHW_O = 2 * 9 * 2 * FF;
constexpr size_t OFF_ACT = OFF_Z;
constexpr size_t OFF_HX = 240 * MiB, OFF_FILT = 336 * MiB, OFF_QN = 368 * MiB, OFF_CKV = 384 * MiB;
constexpr int LDS_BYTES = 147456;

__device__ __forceinline__ unsigned f2bf(float f) { unsigned u = __builtin_bit_cast(unsigned, f); return (u + 0x7fffu + ((u >> 16) & 1u)) >> 16; }
__device__ __forceinline__ unsigned pk2(float lo, float hi) { return f2bf(lo) | (f2bf(hi) << 16); }
typedef __bf16 hbf16x2_t __attribute__((ext_vector_type(2)));
__device__ __forceinline__ unsigned cvtpk(float lo, float hi) { const f32x2 v = {lo, hi}; const hbf16x2_t b = __builtin_convertvector(v, hbf16x2_t); return __builtin_bit_cast(unsigned, b); }
__device__ __forceinline__ float bf2f(unsigned h) { return __builtin_bit_cast(float, h << 16); }
__device__ __forceinline__ float bflo(unsigned w) { return __builtin_bit_cast(float, w << 16); }
__device__ __forceinline__ float bfhi(unsigned w) { return __builtin_bit_cast(float, w & 0xffff0000u); }
__device__ __forceinline__ float wave_sum(float v) {
#pragma unroll
    for (int o = 1; o < 64; o <<= 1) v += __shfl_xor(v, o);
    return v;
}
__device__ __forceinline__ float siluf(float v) { return v * __builtin_amdgcn_rcpf(1.0f + __expf(-v)); }

using pg8::Unit;
typedef pg8::f32x4 gacc_t;
struct EpiStore {
    static constexpr bool PERM = true, AFTER_DRAIN = false;
    bf16_t* O; int ldc;
    const float* ss; const float* shw; int ldshw, row_off, col_off;
    __device__ __forceinline__ void operator()(const gacc_t (&acc)[2][2][4][2], const Unit& u, int wr, int wc, int fr, int fq) const {
        const int row0 = u.pm * 256 + wr * 64 + fr, col0 = u.pn * 256 + wc * 32 + 8 * fq;
        const int ra = row_off + u.pm * 256; const float* shp = shw + (ra < ML ? (ra >> 11) : 8) * ldshw + col_off + col0;
#pragma unroll
        for (int ai = 0; ai < 2; ++ai)
#pragma unroll
            for (int m = 0; m < 4; ++m) { bf16_t* rowp = O + (size_t)(row0 + ai * 128 + m * 16) * ldc + col0;
                float rs = 1.f; if (ss) rs = 1.0f / sqrtf(ss[row_off + row0 + ai * 128 + m * 16] * (1.0f / D) + NEPS);
#pragma unroll
                for (int bj = 0; bj < 2; ++bj) { gacc_t v0 = acc[ai][bj][m][0], v1 = acc[ai][bj][m][1]; u32x4 w;
                    if (ss) { const f32x4 s0 = *(const f32x4*)(shp + bj * 128), s1 = *(const f32x4*)(shp + bj * 128 + 4);
                        v0[0] = v0[0] * rs + s0.x; v0[1] = v0[1] * rs + s0.y; v0[2] = v0[2] * rs + s0.z; v0[3] = v0[3] * rs + s0.w; v1[0] = v1[0] * rs + s1.x; v1[1] = v1[1] * rs + s1.y; v1[2] = v1[2] * rs + s1.z; v1[3] = v1[3] * rs + s1.w; }
                    w.x = pg8::cvt_pk_bf16(v0[0], v0[1]); w.y = pg8::cvt_pk_bf16(v0[2], v0[3]); w.z = pg8::cvt_pk_bf16(v1[0], v1[1]); w.w = pg8::cvt_pk_bf16(v1[2], v1[3]);
                    *(u32x4*)(rowp + bj * 128) = w; } }
    }
};
struct EpiRes {
    static constexpr bool PERM = false, AFTER_DRAIN = false;
    const float* baseL; const float* baseC; float* out; const float* mod; int chunk;
    bf16_t* hu; const float* gn; const float* scl; float* ss;
    __device__ __forceinline__ void operator()(const gacc_t (&acc)[2][2][4][2], const Unit& u, int wr, int wc, int fr, int fq) const {
#pragma unroll
        for (int ai = 0; ai < 2; ++ai)
#pragma unroll
            for (int m = 0; m < 4; ++m) { const int row = u.pm * 256 + ai * 128 + wr * 64 + m * 16 + fr;
                const float* bp = row < ML ? baseL + (size_t)row * D : baseC + (size_t)(row - ML) * D;
                const int mb = row < ML ? (row >> 11) : 8; const float* gp = mod + mb * MODW + chunk * D; float* op = out + (size_t)row * D;
                float sq = 0.f;
#pragma unroll
                for (int bj = 0; bj < 2; ++bj)
#pragma unroll
                    for (int n = 0; n < 2; ++n) { const int col = u.pn * 256 + bj * 128 + wc * 32 + n * 16 + 4 * fq;
                        const f32x4 b = *(const f32x4*)(bp + col), g = *(const f32x4*)(gp + col); const gacc_t a = acc[ai][bj][m][n];
                        f32x4 o; o.x = b.x + g.x * a[0]; o.y = b.y + g.y * a[1]; o.z = b.z + g.z * a[2]; o.w = b.w + g.w * a[3];
                        *(f32x4*)(op + col) = o;
                        if (hu) { const f32x4 gg = *(const f32x4*)(gn + col), sc = *(const f32x4*)(scl + mb * MODW + col);
                            sq += (o.x * o.x + o.y * o.y) + (o.z * o.z + o.w * o.w);
                            u32x2 w; w.x = pg8::cvt_pk_bf16(o.x * gg.x * (1.f + sc.x), o.y * gg.y * (1.f + sc.y)); w.y = pg8::cvt_pk_bf16(o.z * gg.z * (1.f + sc.z), o.w * gg.w * (1.f + sc.w));
                            *(u32x2*)(hu + (size_t)row * D + col) = w; } }
                if (hu) { sq += __shfl_xor(sq, 16); sq += __shfl_xor(sq, 32); if (fq == 0) __hip_atomic_fetch_add(ss + row, sq, __ATOMIC_RELAXED, __HIP_MEMORY_SCOPE_AGENT); } }
    }
};
struct EpiSwiGLU {
    static constexpr bool PERM = true, AFTER_DRAIN = false;
    bf16_t* O; const float* ss; const float* shw;
    __device__ __forceinline__ void operator()(const gacc_t (&acc)[2][2][4][2], const Unit& u, int wr, int wc, int fr, int fq) const {
        const int row0 = u.pm * 256 + wr * 64 + fr, col0 = u.pn * 128 + wc * 32 + 8 * fq;
        const int ra = u.pm * 256; const float* shp = shw + (ra < ML ? (ra >> 11) : 8) * (2 * FF) + u.pn * 256 + wc * 32 + 8 * fq;
        const f32x4 sg0 = *(const f32x4*)shp, sg1 = *(const f32x4*)(shp + 4), su0 = *(const f32x4*)(shp + 128), su1 = *(const f32x4*)(shp + 132);
#pragma unroll
        for (int ai = 0; ai < 2; ++ai)
#pragma unroll
            for (int m = 0; m < 4; ++m) { bf16_t* rowp = O + (size_t)(row0 + ai * 128 + m * 16) * FF + col0;
                const float rs = 1.0f / sqrtf(ss[row0 + ai * 128 + m * 16] * (1.0f / D) + NEPS);
                const gacc_t a0 = acc[ai][0][m][0], a1 = acc[ai][0][m][1], b0 = acc[ai][1][m][0], b1 = acc[ai][1][m][1];
                const float g0[4] = {a0[0] * rs + sg0.x, a0[1] * rs + sg0.y, a0[2] * rs + sg0.z, a0[3] * rs + sg0.w}, g1[4] = {a1[0] * rs + sg1.x, a1[1] * rs + sg1.y, a1[2] * rs + sg1.z, a1[3] * rs + sg1.w};
                const float u0[4] = {b0[0] * rs + su0.x, b0[1] * rs + su0.y, b0[2] * rs + su0.z, b0[3] * rs + su0.w}, u1[4] = {b1[0] * rs + su1.x, b1[1] * rs + su1.y, b1[2] * rs + su1.z, b1[3] * rs + su1.w};
                u32x4 w;
                w.x = pg8::cvt_pk_bf16(siluf(g0[0]) * u0[0], siluf(g0[1]) * u0[1]); w.y = pg8::cvt_pk_bf16(siluf(g0[2]) * u0[2], siluf(g0[3]) * u0[3]);
                w.z = pg8::cvt_pk_bf16(siluf(g1[0]) * u1[0], siluf(g1[1]) * u1[1]); w.w = pg8::cvt_pk_bf16(siluf(g1[2]) * u1[2], siluf(g1[3]) * u1[3]);
                *(u32x4*)rowp = w; }
    }
};
struct EpiRopeQ {
    static constexpr bool PERM = false, AFTER_DRAIN = false;
    bf16_t* O; float qs; const float* rope;
    __device__ __forceinline__ void operator()(const gacc_t (&acc)[2][2][4][2], const Unit& u, int wr, int wc, int fr, int fq) const {
#pragma unroll
        for (int ai = 0; ai < 2; ++ai)
#pragma unroll
            for (int m = 0; m < 4; ++m) { const int row = u.pm * 256 + ai * 128 + wr * 64 + m * 16 + fr; const int t = row & (SEQ - 1);
                bf16_t* rowp = O + (size_t)row * 1536;
#pragma unroll
                for (int bj = 0; bj < 2; ++bj) { const int cgp = u.pn * 256 + bj * 128 + wc * 32; const int gi = (cgp >> 5) % 6;
                    gacc_t a = acc[ai][bj][m][0], b = acc[ai][bj][m][1];
                    if (gi >= 4) { const int pos = gi == 4 ? (t >> 6) : (t & 63); const f32x4* tp = (const f32x4*)(rope + (pos * 16 + 4 * fq) * 2); const f32x4 t0 = tp[0], t1 = tp[1];
                        const float cs[4] = {t0.x, t0.z, t1.x, t1.z}, sn[4] = {t0.y, t0.w, t1.y, t1.w};
#pragma unroll
                        for (int i = 0; i < 4; ++i) { const float x1 = a[i], x2 = b[i]; a[i] = x1 * cs[i] - x2 * sn[i]; b[i] = x1 * sn[i] + x2 * cs[i]; } }
                    u32x2 w0, w1; w0.x = pg8::cvt_pk_bf16(a[0] * qs, a[1] * qs); w0.y = pg8::cvt_pk_bf16(a[2] * qs, a[3] * qs);
                    w1.x = pg8::cvt_pk_bf16(b[0] * qs, b[1] * qs); w1.y = pg8::cvt_pk_bf16(b[2] * qs, b[3] * qs);
                    *(u32x2*)(rowp + cgp + 4 * fq) = w0; *(u32x2*)(rowp + cgp + 16 + 4 * fq) = w1; } }
    }
};
struct EpiKnope {
    static constexpr bool PERM = true, AFTER_DRAIN = false;
    bf16_t* K;
    __device__ __forceinline__ void operator()(const gacc_t (&acc)[2][2][4][2], const Unit& u, int wr, int wc, int fr, int fq) const {
        const int b = u.pm < 64 ? (u.pm >> 3) : (u.pm - 64), T0 = u.pm < 64 ? CTXL + (u.pm & 7) * 256 : 0;
#pragma unroll
        for (int ai = 0; ai < 2; ++ai)
#pragma unroll
            for (int m = 0; m < 4; ++m) { const int rin = ai * 128 + wr * 64 + m * 16 + fr; bf16_t* rowp = K + (size_t)(b * TK + T0 + rin) * 1536;
#pragma unroll
                for (int bj = 0; bj < 2; ++bj) { const int c = u.pn * 256 + bj * 128 + wc * 32 + 8 * fq; const int h = c >> 7, d = c & 127;
                    const gacc_t v0 = acc[ai][bj][m][0], v1 = acc[ai][bj][m][1]; u32x4 w;
                    w.x = pg8::cvt_pk_bf16(v0[0], v0[1]); w.y = pg8::cvt_pk_bf16(v0[2], v0[3]); w.z = pg8::cvt_pk_bf16(v1[0], v1[1]); w.w = pg8::cvt_pk_bf16(v1[2], v1[3]);
                    *(u32x4*)(rowp + h * 192 + d) = w; } }
    }
};
struct EpiVt {
    static constexpr bool PERM = true, AFTER_DRAIN = false;
    bf16_t* Vt;
    __device__ __forceinline__ void operator()(const gacc_t (&acc)[2][2][4][2], const Unit& u, int wr, int wc, int fr, int fq) const {
        const int b = u.pn < 64 ? (u.pn >> 3) : (u.pn - 64), T0 = u.pn < 64 ? CTXL + (u.pn & 7) * 256 : 0;
#pragma unroll
        for (int ai = 0; ai < 2; ++ai)
#pragma unroll
            for (int m = 0; m < 4; ++m) { const int hd = u.pm * 256 + ai * 128 + wr * 64 + m * 16 + fr; bf16_t* rowp = Vt + (size_t)(b * 1024 + hd) * TK + T0;
#pragma unroll
                for (int bj = 0; bj < 2; ++bj) { const int cin = bj * 128 + wc * 32 + 8 * fq;
                    const gacc_t v0 = acc[ai][bj][m][0], v1 = acc[ai][bj][m][1]; u32x4 w;
                    w.x = pg8::cvt_pk_bf16(v0[0], v0[1]); w.y = pg8::cvt_pk_bf16(v0[2], v0[3]); w.z = pg8::cvt_pk_bf16(v1[0], v1[1]); w.w = pg8::cvt_pk_bf16(v1[2], v1[3]);
                    *(u32x4*)(rowp + cin) = w; } }
    }
};

__device__ __forceinline__ void transpose_item(const float* W, int K, int N, bf16_t* WT, int drow0, int k0, int n0, LAS float* scr, int lane) {
    f32x4 wv[8];
#pragma unroll
    for (int i = 0; i < 8; ++i) wv[i] = *(const f32x4*)(W + (size_t)(k0 + 8 * i + (lane >> 3)) * N + n0 + 4 * (lane & 7));
#pragma unroll
    for (int i = 0; i < 8; ++i) { LAS float* sp = scr + (8 * i + (lane >> 3)) * 33 + 4 * (lane & 7); sp[0] = wv[i].x; sp[1] = wv[i].y; sp[2] = wv[i].z; sp[3] = wv[i].w; }
    asm volatile("s_waitcnt lgkmcnt(0)" ::: "memory");
    const int c = lane & 7;
#pragma unroll
    for (int j = 0; j < 4; ++j) { const int n = (lane >> 3) + 8 * j; const LAS float* s = scr + (8 * c) * 33 + n;
        u32x4 o; o.x = pk2(s[0 * 33], s[1 * 33]); o.y = pk2(s[2 * 33], s[3 * 33]); o.z = pk2(s[4 * 33], s[5 * 33]); o.w = pk2(s[6 * 33], s[7 * 33]);
        *(u32x4*)(WT + (size_t)(drow0 + n) * K + k0 + 8 * c) = o; }
    asm volatile("s_waitcnt lgkmcnt(0)" ::: "memory");
}
__device__ __forceinline__ int rowmap(int mode, int n) {
    if (mode == 0) return n;
    if (mode == 1) return 256 * (n >> 7) + (n & 127);
    if (mode == 2) return 256 * (n >> 7) + 128 + (n & 127);
    const int h = n >> 8, d = n & 255; return d < 128 ? h * 128 + d : 1024 + h * 128 + (d - 128);
}
__device__ __forceinline__ void transpose_job(const float* W, int K, int N, bf16_t* WT, int mode, int item, LAS float* scr, int lane) {
    const int nblk = N >> 5, kb = item / nblk, nb = item - kb * nblk;
    transpose_item(W, K, N, WT, rowmap(mode, nb * 32), kb * 64, nb * 32, scr, lane);
}

#define MFMA32(a, b, c) __builtin_amdgcn_mfma_f32_32x32x16_bf16((a), (b), (c), 0, 0, 0)
#define ATT_BAR() asm volatile("s_waitcnt lgkmcnt(0)\n\ts_barrier" ::: "memory")
template <int DK>
__device__ __forceinline__ void attn_unit(LAS unsigned char* lds, const bf16_t* Qp, int q_stride, const bf16_t* Kp, int k_stride, const bf16_t* Vtp, int nkeys, bf16_t* Op, int o_stride, int tid) {
    constexpr int KS = DK * 2 + 16, VS = 144, KCH = DK / 8, KPASS = 64 * KCH / 512, NS = DK / 16, KB = 64 * KS, VB = 128 * VS;
    const int wave = tid >> 6, lane = tid & 63, ql = lane & 31, hi = lane >> 5;
    constexpr int NSR = DK == 128 ? 8 : 6, NSL = NS - NSR, QRS = NSL * 32 + 16;
    LAS unsigned char* Ql = lds + 2 * KB + 2 * VB + wave * (32 * QRS);
    bf16x8 qf[NSR];
    { const bf16_t* qrow = Qp + (size_t)(wave * 32 + ql) * q_stride + 8 * hi;
#pragma unroll
      for (int s = 0; s < NSR; ++s) qf[s] = *(const bf16x8*)(qrow + 16 * s);
#pragma unroll
      for (int s = 0; s < NSL; ++s) *(LAS bf16x8*)(Ql + ql * QRS + (16 * s + 8 * hi) * 2) = *(const bf16x8*)(qrow + 16 * (NSR + s)); }
    f32x16 o[4];
#pragma unroll
    for (int d = 0; d < 4; ++d)
#pragma unroll
        for (int r = 0; r < 16; ++r) o[d][r] = 0.f;
    float m_run = -1e30f, l_run = 0.f;
    const int ntiles = nkeys >> 6;
    u32x4 kreg[KPASS], vreg[2];
#define KSRC(p) ((((p) * 512 + tid) / KCH) * k_stride + (((p) * 512 + tid) % KCH) * 8)
#define KDST(p) ((((p) * 512 + tid) / KCH) * KS + (((p) * 512 + tid) % KCH) * 16)
#define VSRC(p) ((((p) * 512 + tid) >> 3) * TK + (((p) * 512 + tid) & 7) * 8)
#define VDST(p) ((((p) * 512 + tid) >> 3) * VS + ((((p) * 512 + tid) & 7) >> 1) * 32 + ((((p) * 512 + tid) & 1) * 8))
#define K_LOAD(T) do { const bf16_t* kn_ = Kp + (size_t)(T) * 64 * k_stride; _Pragma("unroll") for (int p = 0; p < KPASS; ++p) kreg[p] = *(const u32x4*)(kn_ + KSRC(p)); } while (0)
#define V_LOAD(T) do { const bf16_t* vn_ = Vtp + (T) * 64; _Pragma("unroll") for (int p = 0; p < 2; ++p) vreg[p] = *(const u32x4*)(vn_ + VSRC(p)); } while (0)
#define K_WRITE(BUF) do { LAS unsigned char* kl_ = lds + (BUF) * KB; _Pragma("unroll") for (int p = 0; p < KPASS; ++p) *(LAS u32x4*)(kl_ + KDST(p)) = kreg[p]; } while (0)
#define V_WRITE(BUF) do { LAS unsigned char* vl_ = lds + 2 * KB + (BUF) * VB; _Pragma("unroll") for (int p = 0; p < 2; ++p) { *(LAS u32x2*)(vl_ + VDST(p)) = (u32x2){vreg[p].x, vreg[p].y}; *(LAS u32x2*)(vl_ + VDST(p) + 16) = (u32x2){vreg[p].z, vreg[p].w}; } } while (0)
#define QKT(BUF, D0, D1) do { const LAS unsigned char* Kl_ = lds + (BUF) * KB; \
        _Pragma("unroll") for (int r = 0; r < 16; ++r) { D0[r] = 0.f; D1[r] = 0.f; } \
        _Pragma("unroll") for (int s_ = 0; s_ < NS; ++s_) { \
            const bf16x8 a0_ = *(const LAS bf16x8*)(Kl_ + ql * KS + (16 * s_ + 8 * hi) * 2), a1_ = *(const LAS bf16x8*)(Kl_ + (32 + ql) * KS + (16 * s_ + 8 * hi) * 2); \
            bf16x8 qv_; if (s_ < NSR) qv_ = qf[s_ < NSR ? s_ : 0]; else qv_ = *(const LAS bf16x8*)(Ql + ql * QRS + (16 * (s_ - NSR) + 8 * hi) * 2); \
            D0 = MFMA32(a0_, qv_, D0); D1 = MFMA32(a1_, qv_, D1); } } while (0)
#define FINISH_SM(S0, S1) do { float ls_ = 0.f; \
        _Pragma("unroll") for (int r = 0; r < 16; ++r) { S0[r] = __builtin_amdgcn_exp2f(S0[r] - m_run); S1[r] = __builtin_amdgcn_exp2f(S1[r] - m_run); ls_ += S0[r] + S1[r]; } \
        l_run += ls_; \
        _Pragma("unroll") for (int st = 0; st < 2; ++st) { u32x4 w0_, w1_; \
            w0_.x = cvtpk(S0[8 * st + 0], S0[8 * st + 1]); w0_.y = cvtpk(S0[8 * st + 2], S0[8 * st + 3]); w0_.z = cvtpk(S0[8 * st + 4], S0[8 * st + 5]); w0_.w = cvtpk(S0[8 * st + 6], S0[8 * st + 7]); \
            w1_.x = cvtpk(S1[8 * st + 0], S1[8 * st + 1]); w1_.y = cvtpk(S1[8 * st + 2], S1[8 * st + 3]); w1_.z = cvtpk(S1[8 * st + 4], S1[8 * st + 5]); w1_.w = cvtpk(S1[8 * st + 6], S1[8 * st + 7]); \
            pa[0][st] = __builtin_bit_cast(bf16x8, w0_); pa[1][st] = __builtin_bit_cast(bf16x8, w1_); } } while (0)
#define PV(BUF) do { const LAS unsigned char* Vl_ = lds + 2 * KB + (BUF) * VB; \
        _Pragma("unroll") for (int c_ = 0; c_ < 4; ++c_) _Pragma("unroll") for (int dt = 0; dt < 4; ++dt) { \
            const bf16x8 av_ = *(const LAS bf16x8*)(Vl_ + (32 * dt + ql) * VS + c_ * 32 + hi * 16); o[dt] = MFMA32(av_, pa[c_ >> 1][c_ & 1], o[dt]); } } while (0)
#define ROWMAX(S0, S1, MX) do { MX = S0[0]; _Pragma("unroll") for (int r = 1; r < 16; ++r) MX = fmaxf(MX, S0[r]); _Pragma("unroll") for (int r = 0; r < 16; ++r) MX = fmaxf(MX, S1[r]); MX = fmaxf(MX, __shfl_xor(MX, 32)); } while (0)
#define RESCALE(MX) do { const float mn_ = (MX) > m_run + 8.0f ? (MX) : m_run;     if (__builtin_amdgcn_ballot_w64(mn_ > m_run) != 0ull) { const float al_ = __builtin_amdgcn_exp2f(m_run - mn_); l_run *= al_; \
        _Pragma("unroll") for (int d = 0; d < 4; ++d) _Pragma("unroll") for (int r = 0; r < 16; ++r) o[d][r] *= al_; } m_run = mn_; } while (0)
    f32x16 sA0, sA1, sB0, sB1; bf16x8 pa[2][2]; float mx;
    K_LOAD(0); V_LOAD(0); K_WRITE(0);
    if (ntiles > 1) K_LOAD(1);
    ATT_BAR();
    QKT(0, sA0, sA1);
    if (ntiles > 1) { K_WRITE(1); if (ntiles > 2) K_LOAD(2); }
    V_WRITE(0); if (ntiles > 1) V_LOAD(1);
    ROWMAX(sA0, sA1, mx); RESCALE(mx);
    ATT_BAR();
    for (int j = 1; j < ntiles; ++j) {
        const int kb = j & 1;
        QKT(kb, sB0, sB1);
        FINISH_SM(sA0, sA1);
#pragma unroll
        for (int i_ = 0; i_ < NS * 2; ++i_) { __builtin_amdgcn_sched_group_barrier(0x008, 1, 0); __builtin_amdgcn_sched_group_barrier(0x100, 1, 0); __builtin_amdgcn_sched_group_barrier(0x002, 5, 0); }
        __builtin_amdgcn_sched_barrier(0);
        if (j + 1 < ntiles) { K_WRITE(kb ^ 1); if (j + 2 < ntiles) K_LOAD(j + 2); }
        V_WRITE(kb); if (j + 1 < ntiles) V_LOAD(j + 1);
        __builtin_amdgcn_sched_barrier(0);
        PV(kb ^ 1);
        ROWMAX(sB0, sB1, mx);
#pragma unroll
        for (int i_ = 0; i_ < 16; ++i_) { __builtin_amdgcn_sched_group_barrier(0x008, 1, 0); __builtin_amdgcn_sched_group_barrier(0x100, 1, 0); __builtin_amdgcn_sched_group_barrier(0x002, 2, 0); }
        __builtin_amdgcn_sched_barrier(0);
        RESCALE(mx);
        sA0 = sB0; sA1 = sB1;
        ATT_BAR();
    }
    FINISH_SM(sA0, sA1);
    PV((ntiles - 1) & 1);
    ATT_BAR();
#undef KSRC
#undef KDST
#undef VSRC
#undef VDST
    const float lt = l_run + __shfl_xor(l_run, 32), il = 1.0f / lt;
    bf16_t* orow = Op + (size_t)(wave * 32 + ql) * o_stride;
#pragma unroll
    for (int dt = 0; dt < 4; ++dt)
#pragma unroll
        for (int g = 0; g < 4; ++g) { u32x2 w; w.x = cvtpk(o[dt][4 * g] * il, o[dt][4 * g + 1] * il); w.y = cvtpk(o[dt][4 * g + 2] * il, o[dt][4 * g + 3] * il);
            *(u32x2*)(orow + 32 * dt + 8 * g + 4 * hi) = w; }
}

template <int DK>
__device__ __forceinline__ void attn_unit_simple(LAS unsigned char* lds, const bf16_t* Qp, int q_stride, const bf16_t* Kp, int k_stride, const bf16_t* Vtp, int nkeys, bf16_t* Op, int o_stride, int tid) {
    constexpr int KS = DK * 2 + 16, VS = 144, KCH = DK / 8, KPASS = 64 * KCH / 512, NS = DK / 16, TILE_B = 64 * KS + 128 * VS;
    const int wave = tid >> 6, lane = tid & 63, ql = lane & 31, hi = lane >> 5;
    constexpr int NSR = DK == 128 ? 8 : 6, NSL = NS - NSR, QRS = NSL * 32 + 16;
    LAS unsigned char* Ql = lds + 2 * TILE_B + wave * (32 * QRS);
    bf16x8 qf[NSR];
    { const bf16_t* qrow = Qp + (size_t)(wave * 32 + ql) * q_stride + 8 * hi;
#pragma unroll
      for (int s = 0; s < NSR; ++s) qf[s] = *(const bf16x8*)(qrow + 16 * s);
#pragma unroll
      for (int s = 0; s < NSL; ++s) *(LAS bf16x8*)(Ql + ql * QRS + (16 * s + 8 * hi) * 2) = *(const bf16x8*)(qrow + 16 * (NSR + s)); }
    f32x16 o[4];
#pragma unroll
    for (int d = 0; d < 4; ++d)
#pragma unroll
        for (int r = 0; r < 16; ++r) o[d][r] = 0.f;
    float m_run = -1e30f, l_run = 0.f;
    const int ntiles = nkeys >> 6;
    u32x4 kreg[KPASS], vreg[2];
#define KSRC(p) ((((p) * 512 + tid) / KCH) * k_stride + (((p) * 512 + tid) % KCH) * 8)
#define KDST(p) ((((p) * 512 + tid) / KCH) * KS + (((p) * 512 + tid) % KCH) * 16)
#define VSRC(p) ((((p) * 512 + tid) >> 3) * TK + (((p) * 512 + tid) & 7) * 8)
#define VDST(p) ((((p) * 512 + tid) >> 3) * VS + ((((p) * 512 + tid) & 7) >> 1) * 32 + ((((p) * 512 + tid) & 1) * 8))
#define ATT_LOAD(T) do { const bf16_t* kn_ = Kp + (size_t)(T) * 64 * k_stride; const bf16_t* vn_ = Vtp + (T) * 64; \
        _Pragma("unroll") for (int p = 0; p < KPASS; ++p) kreg[p] = *(const u32x4*)(kn_ + KSRC(p)); \
        _Pragma("unroll") for (int p = 0; p < 2; ++p) vreg[p] = *(const u32x4*)(vn_ + VSRC(p)); } while (0)
#define ATT_WRITE(BUF) do { LAS unsigned char* kl_ = lds + (BUF) * TILE_B; LAS unsigned char* vl_ = kl_ + 64 * KS; \
        _Pragma("unroll") for (int p = 0; p < KPASS; ++p) *(LAS u32x4*)(kl_ + KDST(p)) = kreg[p]; \
        _Pragma("unroll") for (int p = 0; p < 2; ++p) { *(LAS u32x2*)(vl_ + VDST(p)) = (u32x2){vreg[p].x, vreg[p].y}; *(LAS u32x2*)(vl_ + VDST(p) + 16) = (u32x2){vreg[p].z, vreg[p].w}; } } while (0)
    if (wave < 4) __builtin_amdgcn_s_setprio(2);
    ATT_LOAD(0); ATT_WRITE(0);
    if (ntiles > 1) ATT_LOAD(1);
    ATT_BAR();
    for (int tile = 0; tile < ntiles; ++tile) {
        const int cur = tile & 1;
        if (tile + 1 < ntiles) { ATT_WRITE(cur ^ 1); if (tile + 2 < ntiles) ATT_LOAD(tile + 2); }
        LAS unsigned char* Kl = lds + cur * TILE_B; LAS unsigned char* Vl = Kl + 64 * KS;
        f32x16 s0, s1;
#pragma unroll
        for (int r = 0; r < 16; ++r) { s0[r] = 0.f; s1[r] = 0.f; }
        bf16x8 kf[2][4], qx[2][2];
#define LOADK(BUF, GI) _Pragma("unroll") for (int j = 0; j < 2; ++j) { const int s_ = 2 * (GI) + j; \
            kf[BUF][2 * j] = *(const LAS bf16x8*)(Kl + ql * KS + (16 * s_ + 8 * hi) * 2); kf[BUF][2 * j + 1] = *(const LAS bf16x8*)(Kl + (32 + ql) * KS + (16 * s_ + 8 * hi) * 2); \
            if (s_ >= NSR) qx[BUF][j] = *(const LAS bf16x8*)(Ql + ql * QRS + (16 * (s_ - NSR) + 8 * hi) * 2); }
        LOADK(0, 0)
#pragma unroll
        for (int gi = 0; gi < NS / 2; ++gi) {
            if (gi + 1 < NS / 2) { LOADK((gi + 1) & 1, gi + 1) }
            __builtin_amdgcn_sched_barrier(0);
#pragma unroll
            for (int j = 0; j < 2; ++j) { const int s_ = 2 * gi + j; const bf16x8 qv = s_ < NSR ? qf[s_ < NSR ? s_ : 0] : qx[gi & 1][j];
                s0 = MFMA32(kf[gi & 1][2 * j], qv, s0); s1 = MFMA32(kf[gi & 1][2 * j + 1], qv, s1); }
            __builtin_amdgcn_sched_barrier(0);
        }
#undef LOADK
        u32x4 vf[2][4];
#define LOADV(BUF, CC) _Pragma("unroll") for (int d_ = 0; d_ < 4; ++d_) vf[BUF][d_] = *(const LAS u32x4*)(Vl + (32 * d_ + ql) * VS + (CC) * 32 + hi * 16);
        LOADV(0, 0)
        __builtin_amdgcn_sched_barrier(0);
        float mx = s0[0];
#pragma unroll
        for (int r = 1; r < 16; ++r) mx = fmaxf(mx, s0[r]);
#pragma unroll
        for (int r = 0; r < 16; ++r) mx = fmaxf(mx, s1[r]);
        mx = fmaxf(mx, __shfl_xor(mx, 32));
        const float m_new = mx > m_run + 8.0f ? mx : m_run;
        if (__builtin_amdgcn_ballot_w64(m_new > m_run) != 0ull) {
            const float alpha = __builtin_amdgcn_exp2f(m_run - m_new);
            l_run *= alpha;
#pragma unroll
            for (int d = 0; d < 4; ++d)
#pragma unroll
                for (int r = 0; r < 16; ++r) o[d][r] *= alpha;
        }
        float ls = 0.f;
#pragma unroll
        for (int r = 0; r < 16; ++r) { s0[r] = __builtin_amdgcn_exp2f(s0[r] - m_new); s1[r] = __builtin_amdgcn_exp2f(s1[r] - m_new); ls += s0[r] + s1[r]; }
        l_run += ls; m_run = m_new;
        bf16x8 pa[2][2];
#pragma unroll
        for (int st = 0; st < 2; ++st) {
            u32x4 w0, w1;
            w0.x = cvtpk(s0[8 * st + 0], s0[8 * st + 1]); w0.y = cvtpk(s0[8 * st + 2], s0[8 * st + 3]); w0.z = cvtpk(s0[8 * st + 4], s0[8 * st + 5]); w0.w = cvtpk(s0[8 * st + 6], s0[8 * st + 7]);
            w1.x = cvtpk(s1[8 * st + 0], s1[8 * st + 1]); w1.y = cvtpk(s1[8 * st + 2], s1[8 * st + 3]); w1.z = cvtpk(s1[8 * st + 4], s1[8 * st + 5]); w1.w = cvtpk(s1[8 * st + 6], s1[8 * st + 7]);
            pa[0][st] = __builtin_bit_cast(bf16x8, w0); pa[1][st] = __builtin_bit_cast(bf16x8, w1);
        }
        __builtin_amdgcn_sched_barrier(0);
#pragma unroll
        for (int dt = 0; dt < 4; ++dt) {
            if (dt < 3) { LOADV((dt + 1) & 1, dt + 1) }
            __builtin_amdgcn_sched_barrier(0);
#pragma unroll
            for (int d_ = 0; d_ < 4; ++d_) o[d_] = MFMA32(__builtin_bit_cast(bf16x8, vf[dt & 1][d_]), pa[dt >> 1][dt & 1], o[d_]);
            __builtin_amdgcn_sched_barrier(0);
        }
#undef LOADV
        ATT_BAR();
    }
    __builtin_amdgcn_s_setprio(0);
    const float lt = l_run + __shfl_xor(l_run, 32), il = 1.0f / lt;
    bf16_t* orow = Op + (size_t)(wave * 32 + ql) * o_stride;
#pragma unroll
    for (int dt = 0; dt < 4; ++dt)
#pragma unroll
        for (int g = 0; g < 4; ++g) { u32x2 w; w.x = cvtpk(o[dt][4 * g] * il, o[dt][4 * g + 1] * il); w.y = cvtpk(o[dt][4 * g + 2] * il, o[dt][4 * g + 3] * il);
            *(u32x2*)(orow + 32 * dt + 8 * g + 4 * hi) = w; }
}

#define XB_TMO      128
#define XB_XCNT(j)  (256  + 64 * (j))
#define XB_XSUB(j)  (1280 + 64 * (j))
#define XB_XGEN(j)  (2304 + 64 * (j))
#define XB_TOP      3328
#define XB_TOPGEN   3392
#define XCD_BAR_WORDS 3456
#define XB_SPIN_CAP (1u << 18)

__device__ __forceinline__ unsigned xb_ld(unsigned* p)              { return __hip_atomic_load(p, __ATOMIC_RELAXED, __HIP_MEMORY_SCOPE_AGENT); }
__device__ __forceinline__ unsigned xb_add(unsigned* p, unsigned v) { return __hip_atomic_fetch_add(p, v, __ATOMIC_RELAXED, __HIP_MEMORY_SCOPE_AGENT); }
__device__ __forceinline__ unsigned xb_xcc_id() { return (unsigned)__builtin_amdgcn_s_getreg((3 << 11) | 20) & 0xFu; }
#define XB_SPIN(cond, bar) do { unsigned _sp = 0; while (cond) { __builtin_amdgcn_s_sleep(1); \
    if ((++_sp & 255u) == 0u) { if (xb_ld(&(bar)[XB_TMO])) break; if (_sp > XB_SPIN_CAP) { atomicAdd(&(bar)[XB_TMO], 1u); break; } } } } while (0)

struct XcdBarrier {
    unsigned* bar; unsigned x;
    volatile LAS unsigned* st;
};

__device__ __forceinline__ XcdBarrier xcd_barrier_post(unsigned* bar, volatile LAS unsigned* st) {
    XcdBarrier b; b.bar = bar; b.x = xb_xcc_id(); b.st = st;
    if (threadIdx.x == 0) (void)xb_add(&bar[XB_XCNT(b.x)], 1u);
    return b;
}
__device__ __forceinline__ void xcd_barrier_complete(unsigned* bar, unsigned x, unsigned& nloc, unsigned& nx) {
    const unsigned G = gridDim.x * gridDim.y * gridDim.z;
    unsigned sum, cnt, mine, sp = 0u;
    for (;;) {
        sum = 0u; cnt = 0u; mine = 0u;
#pragma unroll
        for (unsigned j = 0; j < 16; ++j) { const unsigned c = xb_ld(&bar[XB_XCNT(j)]); sum += c; cnt += (c > 0u) ? 1u : 0u; mine = (j == x) ? c : mine; }
        if (sum == G) break;
        __builtin_amdgcn_s_sleep(1);
        if ((++sp & 255u) == 0u) { if (xb_ld(&bar[XB_TMO])) break; if (sp > XB_SPIN_CAP) { atomicAdd(&bar[XB_TMO], 1u); break; } }
    }
    nloc = mine > 0u ? mine : 1u; nx = cnt > 0u ? cnt : 1u;
}

__device__ __forceinline__ void xcd_barrier(const XcdBarrier& b) {
    asm volatile("s_waitcnt vmcnt(0)" ::: "memory");
    __syncthreads();
    if (threadIdx.x == 0) {
        unsigned* bar = b.bar;
        __builtin_amdgcn_s_waitcnt(0);
        unsigned nloc = b.st[0], nx = b.st[1];
        if (nloc == 0u) { xcd_barrier_complete(bar, b.x, nloc, nx); b.st[0] = nloc; b.st[1] = nx; }
        const unsigned old = xb_add(&bar[XB_XSUB(b.x)], 1u);
        const unsigned gen = old / nloc;
        if (old + 1u == (gen + 1u) * nloc) {
            __builtin_amdgcn_fence(__ATOMIC_RELEASE, "agent");
            asm volatile("s_waitcnt vmcnt(0)" ::: "memory");
            const unsigned og = xb_add(&bar[XB_TOP], 1u);
            const unsigned tg = og / nx;
            if (og + 1u == (tg + 1u) * nx) xb_add(&bar[XB_TOPGEN], 1u);
            else XB_SPIN(xb_ld(&bar[XB_TOPGEN]) == tg, bar);
            __builtin_amdgcn_fence(__ATOMIC_ACQUIRE, "agent");
            xb_add(&bar[XB_XGEN(b.x)], 1u);
            asm volatile("s_waitcnt vmcnt(0)" ::: "memory");
        } else {
            XB_SPIN(xb_ld(&bar[XB_XGEN(b.x)]) == gen, bar);
            __builtin_amdgcn_fence(__ATOMIC_ACQUIRE, "agent");
            asm volatile("s_waitcnt vmcnt(0)" ::: "memory");
        }
    }
    __syncthreads();
}


struct Args { const float* in[37]; float* out; unsigned char* ws; int ph_lo, ph_hi; };
constexpr int NPHASE = 19;
#ifndef PHMASK
#define PHMASK 0xFFFFFFFFu
#endif
#define EN(k) (((PHMASK) >> (k)) & 1u)
#ifndef SUBMASK
#define SUBMASK 0xFFFFFFFFu
#endif
#define SUB(k) (((SUBMASK) >> (k)) & 1u)

template <int PH>
__device__ __forceinline__ void run_phase(const Args& args, LAS unsigned char* lds) {
    constexpr int ph = PH;
    const int tid = threadIdx.x, lane = tid & 63, wave = __builtin_amdgcn_readfirstlane(tid >> 6);
    const int G = gridDim.x, bid = blockIdx.x;
    const int gw = bid * 8 + wave, NGW = G * 8;
    unsigned char* ws = args.ws;
    const float* x_in = args.in[0]; const float* ctx_in = args.in[2];
    float* MOD = (float*)(ws + OFF_MOD); float* H3 = (float*)(ws + OFF_H3); float* XR = (float*)(ws + OFF_XR);
    bf16_t* Hb = (bf16_t*)(ws + OFF_H); bf16_t* Zb = (bf16_t*)(ws + OFF_Z); bf16_t* ZCb = (bf16_t*)(ws + OFF_ZC); bf16_t* MIXb = (bf16_t*)(ws + OFF_MIX);
    bf16_t* ACTb = (bf16_t*)(ws + OFF_ACT); bf16_t* Qb = (bf16_t*)(ws + OFF_Q); bf16_t* Kb = (bf16_t*)(ws + OFF_K); bf16_t* VTb = (bf16_t*)(ws + OFF_VT);
    bf16_t* HXb = (bf16_t*)(ws + OFF_HX); float* FILT = (float*)(ws + OFF_FILT); bf16_t* QNb = (bf16_t*)(ws + OFF_QN); bf16_t* CKVb = (bf16_t*)(ws + OFF_CKV);
    (void)lane; (void)gw; (void)NGW; (void)x_in; (void)ctx_in; (void)MOD; (void)H3; (void)XR; (void)Hb; (void)Zb; (void)ZCb; (void)MIXb; (void)ACTb; (void)Qb; (void)Kb; (void)VTb; (void)HXb; (void)FILT; (void)QNb; (void)CKVb;

        if (EN(0) && ph == 0) {
            {
                LAS float* scr = (LAS float*)(lds + wave * 16384);
                constexpr int I0 = 32 * 112, I1 = 32 * 64, I2 = 32 * 122, I3 = 32 * 64, I4 = 8 * 48, I5 = 4 * 64, IG = 32 * 176, ID = 88 * 64;
                constexpr int NIT = I0 + I1 + I2 + I3 + I4 + I5 + 4 * IG + 2 * ID;
                for (int it = gw; it < NIT; it += NGW) {
                    int r = it;
                    if (r < I0) { transpose_job(args.in[8], D, INE, (bf16_t*)(ws + OFF_WEIN), 0, r, scr, lane); continue; } r -= I0;
                    if (r < I1) { transpose_job(args.in[9], D, D, (bf16_t*)(ws + OFF_WEOUT), 0, r, scr, lane); continue; } r -= I1;
                    if (r < I2) { transpose_job(args.in[16], D, INO, (bf16_t*)(ws + OFF_WOIN), 0, r, scr, lane); continue; } r -= I2;
                    if (r < I3) { transpose_job(args.in[17], D, D, (bf16_t*)(ws + OFF_WOOUT), 0, r, scr, lane); continue; } r -= I3;
                    if (r < I4) { transpose_job(args.in[31], 512, 1536, (bf16_t*)(ws + OFF_WUQ), 0, r, scr, lane); continue; } r -= I4;
                    if (r < I5) { transpose_job(args.in[32], 256, 2048, (bf16_t*)(ws + OFF_WUKV), 3, r, scr, lane); continue; } r -= I5;
                    if (r < IG) { transpose_job(args.in[33], D, FF, (bf16_t*)(ws + OFF_WGU0), 1, r, scr, lane); continue; } r -= IG;
                    if (r < IG) { transpose_job(args.in[34], D, FF, (bf16_t*)(ws + OFF_WGU0), 2, r, scr, lane); continue; } r -= IG;
                    if (r < IG) { transpose_job(args.in[33] + (size_t)D * FF, D, FF, (bf16_t*)(ws + OFF_WGU1), 1, r, scr, lane); continue; } r -= IG;
                    if (r < IG) { transpose_job(args.in[34] + (size_t)D * FF, D, FF, (bf16_t*)(ws + OFF_WGU1), 2, r, scr, lane); continue; } r -= IG;
                    if (r < ID) { transpose_job(args.in[35], FF, D, (bf16_t*)(ws + OFF_WDN0), 0, r, scr, lane); continue; } r -= ID;
                    transpose_job(args.in[35] + (size_t)FF * D, FF, D, (bf16_t*)(ws + OFF_WDN1), 0, r, scr, lane);
                }
                { u32x4* zp = (u32x4*)((bf16_t*)(ws + OFF_WOIN) + (size_t)INO * D); const int nz = (INOP - INO) * D / 8;
                  for (int i = bid * 512 + tid; i < nz; i += G * 512) zp[i] = (u32x4){0u, 0u, 0u, 0u}; }
            }
            __syncthreads();
            {
                LAS float* cond = (LAS float*)lds; LAS float* red = (LAS float*)(lds + 9 * 2048 * 4);
                for (int idx = tid; idx < 9 * 2048; idx += 512) { const int r = idx >> 11, k = idx & 2047; const float v = r < 8 ? args.in[1][r * 2048 + k] : args.in[3][k]; cond[idx] = v / (1.0f + expf(-v)); }
                __syncthreads();
                for (int unit = bid; unit < 256; unit += G) {
                    const int layer = unit >> 7, col0 = (unit & 127) * 96;
                    if (tid < 384) {
                        const int cg4 = tid % 24, ks = tid / 24;
                        const float* wp = args.in[4] + ((size_t)layer * 2048 + ks * 128) * MODW + col0 + cg4 * 4;
                        const LAS float* cp = cond + ks * 128;
                        f32x4 acc[9];
#pragma unroll
                        for (int r = 0; r < 9; ++r) acc[r] = (f32x4){0.f, 0.f, 0.f, 0.f};
#pragma unroll 8
                        for (int kk = 0; kk < 128; ++kk) { const f32x4 w = *(const f32x4*)(wp + (size_t)kk * MODW);
#pragma unroll
                            for (int r = 0; r < 9; ++r) { const float cv = cp[r * 2048 + kk]; acc[r] += w * cv; } }
#pragma unroll
                        for (int r = 0; r < 9; ++r) *(LAS f32x4*)(red + (ks * 9 + r) * 96 + cg4 * 4) = acc[r];
                    }
                    __syncthreads();
                    for (int idx = tid; idx < 9 * 96; idx += 512) { const int r = idx / 96, cc = idx - r * 96; float s = 0.f;
#pragma unroll
                        for (int ks = 0; ks < 16; ++ks) s += red[(ks * 9 + r) * 96 + cc];
                        MOD[(layer * 9 + r) * MODW + col0 + cc] = s + args.in[5][layer * MODW + col0 + cc]; }
                    __syncthreads();
                }
            }
            { float* ssz = (float*)(ws + OFF_SS); for (int i = bid * 512 + tid; i < 3 * MT; i += G * 512) ssz[i] = 0.f; }
            {
                { float* rt = (float*)(ws + OFF_ROPE32);
                  for (int i = bid * 512 + tid; i < 64 * 32; i += G * 512) { const int pos = i >> 5, jj = i & 31; const float ang = (float)pos * exp2f(-(float)jj * (LOG2_THETA / 32.0f)); rt[2 * i] = cosf(ang); rt[2 * i + 1] = sinf(ang); } }
                { float* rt = (float*)(ws + OFF_ROPE16);
                  for (int i = bid * 512 + tid; i < 64 * 16; i += G * 512) { const int pos = i >> 4, jj = i & 15; const float ang = (float)pos * exp2f(-(float)jj * (LOG2_THETA / 16.0f)); rt[2 * i] = cosf(ang); rt[2 * i + 1] = sinf(ang); } }
                const float* w1 = args.in[20]; const float* b1 = args.in[21]; const float* w2 = args.in[22]; const float* b2 = args.in[23];
                const float* w3 = args.in[24]; const float* b3 = args.in[25]; const float* fr = args.in[27];
                for (int pos = gw; pos < SEQ; pos += NGW) {
                    const float tl = (float)pos / (float)(SEQ - 1), wt = (6.283185307179586f / (float)SEQ) * (float)pos;
                    float a = b1[lane] + tl * w1[lane];
                    for (int i = 0; i < 16; ++i) { const float f = 1e-4f + (float)i * ((15.0f - 1e-4f) / 15.0f); const float ang = f * wt;
                        a += cosf(ang) * w1[(1 + i) * 64 + lane] - sinf(ang) * w1[(17 + i) * 64 + lane]; }
                    const float h1 = sinf(fr[lane] * a);
                    float a2 = b2[lane];
                    for (int i = 0; i < 64; ++i) a2 += __shfl(h1, i) * w2[i * 64 + lane];
                    const float h2 = sinf(fr[64 + lane] * a2);
                    float a3 = b3[lane];
                    for (int i = 0; i < 64; ++i) a3 += __shfl(h2, i) * w3[i * 64 + lane];
                    H3[pos * 64 + lane] = sinf(fr[128 + lane] * a3);
                }
            }
        }
        if (EN(1) && (ph == 1 || ph == 6 || ph == 9 || ph == 15)) {
            const int layer = ph >= 9 ? 1 : 0; const bool ffn = (ph == 6 || ph == 15);
            const float* g = (ffn ? args.in[7] : args.in[6]) + layer * D;
            const float* srcL = ph == 1 ? x_in : XR; const float* srcC = ph == 1 ? ctx_in : XR + (size_t)ML * D;
            const float* modL = MOD + layer * 9 * MODW + (ffn ? 3 : 0) * D;
            const int rend = ph == 15 ? ML : MT;
            f32x4 v[8], nv[8];
            if (gw < rend) { const float* xr = gw < ML ? srcL + (size_t)gw * D : srcC + (size_t)(gw - ML) * D;
#pragma unroll
                for (int j = 0; j < 8; ++j) v[j] = ((const f32x4*)xr)[lane + 64 * j]; }
            for (int row = gw; row < rend; row += NGW) {
                const int nrow = row + NGW;
                if (nrow < rend) { const float* xn = nrow < ML ? srcL + (size_t)nrow * D : srcC + (size_t)(nrow - ML) * D;
#pragma unroll
                    for (int j = 0; j < 8; ++j) nv[j] = ((const f32x4*)xn)[lane + 64 * j]; }
                const float* mr = modL + (row < ML ? (row >> 11) : 8) * MODW;
                float ss = 0.f;
#pragma unroll
                for (int j = 0; j < 8; ++j) ss += (v[j].x * v[j].x + v[j].y * v[j].y) + (v[j].z * v[j].z + v[j].w * v[j].w);
                const float rs = 1.0f / sqrtf(wave_sum(ss) * (1.0f / D) + NEPS);
                u32x2* op = (u32x2*)(Hb + (size_t)row * D);
#pragma unroll
                for (int j = 0; j < 8; ++j) { const int c4 = lane + 64 * j; const f32x4 gg = ((const f32x4*)g)[c4], sh = ((const f32x4*)mr)[c4], sc = ((const f32x4*)(mr + D))[c4];
                    u32x2 w; w.x = pk2(v[j].x * rs * gg.x * (1.f + sc.x) + sh.x, v[j].y * rs * gg.y * (1.f + sc.y) + sh.y);
                    w.y = pk2(v[j].z * rs * gg.z * (1.f + sc.z) + sh.z, v[j].w * rs * gg.w * (1.f + sc.w) + sh.w); op[c4] = w; }
#pragma unroll
                for (int j = 0; j < 8; ++j) v[j] = nv[j];
            }
        }
        if (EN(1) && ph == 1) {
            LAS float* shl = (LAS float*)lds;
            float* SHW = (float*)(ws + OFF_SHW);
#pragma unroll 1
            for (int job = 0; job < 3; ++job) {
                const float* shsrc = MOD + (job == 0 ? 0 : 9 * MODW) + (job == 2 ? 0 : 3) * D;
                const bf16_t* Wt = (const bf16_t*)(ws + (job == 0 ? OFF_WGU0 : job == 1 ? OFF_WGU1 : OFF_WOIN));
                const int N = job == 2 ? INOP : 2 * FF; float* dst = SHW + (job == 0 ? SHW_F0 : job == 1 ? SHW_F1 : SHW_O);
                __syncthreads();
                for (int idx = tid; idx < 9 * 512; idx += 512) { const int r = idx >> 9, k4 = idx & 511; *(LAS f32x4*)(shl + r * 2048 + k4 * 4) = *(const f32x4*)(shsrc + r * MODW + k4 * 4); }
                __syncthreads();
                for (int n = gw; n < N; n += NGW) {
                    u32x2 wv[8];
#pragma unroll
                    for (int i = 0; i < 8; ++i) wv[i] = *(const u32x2*)(Wt + (size_t)n * D + 4 * (lane + 64 * i));
                    float wf[32];
#pragma unroll
                    for (int i = 0; i < 8; ++i) { wf[4 * i] = bflo(wv[i].x); wf[4 * i + 1] = bfhi(wv[i].x); wf[4 * i + 2] = bflo(wv[i].y); wf[4 * i + 3] = bfhi(wv[i].y); }
#pragma unroll 1
                    for (int r = 0; r < 9; ++r) { float a = 0.f;
#pragma unroll
                        for (int i = 0; i < 8; ++i) { const f32x4 sv = *(const LAS f32x4*)(shl + r * 2048 + 4 * (lane + 64 * i)); a += (wf[4 * i] * sv.x + wf[4 * i + 1] * sv.y) + (wf[4 * i + 2] * sv.z + wf[4 * i + 3] * sv.w); }
                        const float t = wave_sum(a); if (lane == 0) dst[r * N + n] = t; }
                }
            }
        }
        if (EN(2) && (ph == 2 || ph == 10)) {
            const int nsub = ph == 2 ? 1 : 2;
#pragma unroll 1
            for (int sub = 0; sub < nsub; ++sub) {
                const bf16_t* A = sub ? Hb + (size_t)ML * D : Hb;
                const bf16_t* Bt = ph == 2 ? (const bf16_t*)(ws + OFF_WEIN) : (sub ? (const bf16_t*)(ws + OFF_WOIN) + (size_t)3584 * D : (const bf16_t*)(ws + OFF_WOIN));
                const int Mr = ph == 2 ? MT : (sub ? MC : ML), Nr = ph == 2 ? INE : (sub ? 512 : INOP);
                pg8::Gemm g{A, Bt, Mr, Nr, D}; pg8::StaticOrder S; S.init(Mr, Nr, G, bid);
                EpiStore E{sub ? ZCb : Zb, Nr, ph == 2 ? (const float*)nullptr : (const float*)(ws + OFF_SS) + MT, (const float*)(ws + OFF_SHW) + SHW_O, INOP, sub ? ML : 0, sub ? 3584 : 0};
                pg8::gemm_phase<EpiStore, pg8::StaticOrder, true, true>(lds, g, S, E);
            }
        }
        if (EN(3) && ph == 3) {
            if (SUB(0)) {
                const float* qg = args.in[14]; const float* kg = args.in[15];
                const int l16 = lane & 15, gq = lane >> 4;
                const float QS = 0.08838834764831845f * LOG2E;
                const f32x4 qga = *(const f32x4*)(qg + 8 * l16), qgb = *(const f32x4*)(qg + 8 * l16 + 4), kga = *(const f32x4*)(kg + 8 * l16), kgb = *(const f32x4*)(kg + 8 * l16 + 4);
                const float qgv[8] = {qga.x, qga.y, qga.z, qga.w, qgb.x, qgb.y, qgb.z, qgb.w}, kgv[8] = {kga.x, kga.y, kga.z, kga.w, kgb.x, kgb.y, kgb.z, kgb.w};
                const bool first = (l16 & 4) == 0;
                for (int grp = gw; grp < MT / 4; grp += NGW) {
                    const int row = grp * 4 + gq;
                    const bool lat = row < ML; const int b = lat ? (row >> 11) : ((row - ML) >> 8); const int t = lat ? (row & 2047) : ((row - ML) & 255);
                    const int Tpos = lat ? CTXL + t : t;
                    float cs[8], sn[8];
#pragma unroll
                    for (int k = 0; k < 8; ++k) { cs[k] = 1.f; sn[k] = 0.f; }
                    if (lat) { const int pos = l16 < 8 ? (t >> 6) : (t & 63); const f32x4* tp = (const f32x4*)((const float*)(ws + OFF_ROPE32) + (pos * 32 + 8 * (l16 & 3)) * 2);
#pragma unroll
                        for (int k2 = 0; k2 < 4; ++k2) { const f32x4 tv = tp[k2]; cs[2 * k2] = tv.x; sn[2 * k2] = tv.y; cs[2 * k2 + 1] = tv.z; sn[2 * k2 + 1] = tv.w; } }
                    const bf16_t* zr = Zb + (size_t)row * INE + 2048 + 8 * l16;
                    u32x4 raw[12];
#pragma unroll
                    for (int h = 0; h < 12; ++h) raw[h] = *(const u32x4*)(zr + h * 128);
#pragma unroll
                    for (int h = 0; h < 10; ++h) {
                        float x[8] = {bflo(raw[h].x), bfhi(raw[h].x), bflo(raw[h].y), bfhi(raw[h].y), bflo(raw[h].z), bfhi(raw[h].z), bflo(raw[h].w), bfhi(raw[h].w)};
                        float ss = 0.f;
#pragma unroll
                        for (int k = 0; k < 8; ++k) ss += x[k] * x[k];
                        ss += __shfl_xor(ss, 1); ss += __shfl_xor(ss, 2); ss += __shfl_xor(ss, 4); ss += __shfl_xor(ss, 8);
                        const float rs = 1.0f / sqrtf(ss * (1.0f / 128.0f) + NEPS);
                        float o[8];
#pragma unroll
                        for (int k = 0; k < 8; ++k) { const float y = x[k] * rs * (h < 8 ? qgv[k] : kgv[k]); const float yo = __shfl_xor(y, 4);
                            o[k] = first ? (y * cs[k] - yo * sn[k]) : (yo * sn[k] + y * cs[k]); if (h < 8) o[k] *= QS; }
                        u32x4 w; w.x = cvtpk(o[0], o[1]); w.y = cvtpk(o[2], o[3]); w.z = cvtpk(o[4], o[5]); w.w = cvtpk(o[6], o[7]);
                        if (h < 8) *(u32x4*)(Qb + (size_t)row * 1024 + h * 128 + 8 * l16) = w;
                        else *(u32x4*)(Kb + (size_t)(b * TK + Tpos) * 256 + (h - 8) * 128 + 8 * l16) = w;
                    }
#pragma unroll
                    for (int h = 0; h < 2; ++h) { bf16_t* vp = VTb + (size_t)((b * 2 + h) * 128 + 8 * l16) * TK + Tpos; const u32x4 r = raw[10 + h];
                        vp[0] = (bf16_t)(r.x & 0xffffu); vp[TK] = (bf16_t)(r.x >> 16); vp[2 * TK] = (bf16_t)(r.y & 0xffffu); vp[3 * TK] = (bf16_t)(r.y >> 16);
                        vp[4 * TK] = (bf16_t)(r.z & 0xffffu); vp[5 * TK] = (bf16_t)(r.z >> 16); vp[6 * TK] = (bf16_t)(r.w & 0xffffu); vp[7 * TK] = (bf16_t)(r.w >> 16); }
                }
            }
            if (SUB(1)) {
                const float* dww = args.in[10]; const float* dwb = args.in[11]; const float* lng = args.in[12]; const float* lnb = args.in[13];
                LAS float* red = (LAS float*)lds;
                LAS float* obuf = (LAS float*)(lds + 1024);
                const int c0 = 2 * tid;
                float w0[31], w1[31];
#pragma unroll
                for (int k = 0; k < 31; ++k) { const f32x2 wv = *(const f32x2*)(dww + k * 1024 + c0); w0[k] = wv.x; w1[k] = wv.y; }
                const f32x2 bias = *(const f32x2*)(dwb + c0), lg = *(const f32x2*)(lng + c0), lb = *(const f32x2*)(lnb + c0);
                for (int unit = bid; unit < MT / 16; unit += G) {
                    const int row0 = unit * 16; const bool lat = row0 < ML; const int L = lat ? SEQ : CTXL;
                    const int p0 = lat ? (row0 & 2047) : ((row0 - ML) & 255); const int seq0 = row0 - p0;
                    float a0[16], a1[16];
#pragma unroll
                    for (int o = 0; o < 16; ++o) { a0[o] = bias.x; a1[o] = bias.y; }
                    unsigned ca[8], cgt[8], na[8], ng[8];
#define CONF_LOAD(DA, DG, CH) _Pragma("unroll") for (int k = 0; k < 8; ++k) { const int q = p0 - 15 + 8 * (CH) + k; const int qc = q < 0 ? 0 : (q >= L ? L - 1 : q); \
                        const bf16_t* rowp = Zb + (size_t)(seq0 + qc) * INE; DA[k] = *(const unsigned*)(rowp + (unsigned)c0); DG[k] = *(const unsigned*)(rowp + 1024 + (unsigned)c0); }
                    CONF_LOAD(ca, cgt, 0)
#pragma unroll
                    for (int ch = 0; ch < 6; ++ch) {
                        if (ch < 5) { CONF_LOAD(na, ng, ch + 1) }
                        asm volatile("" ::: "memory");
#pragma unroll
                        for (int k = 0; k < 8; ++k) { const int i = 8 * ch + k; if (i < 46) { const int q = p0 - 15 + i; float u0 = 0.f, u1 = 0.f;
                            if (q >= 0 && q < L) { u0 = bflo(ca[k]) / (1.0f + __expf(-bflo(cgt[k]))); u1 = bfhi(ca[k]) / (1.0f + __expf(-bfhi(cgt[k]))); }
#pragma unroll
                            for (int o = 0; o < 16; ++o) { const int kk = i - o; if (kk >= 0 && kk <= 30) { a0[o] += w0[kk] * u0; a1[o] += w1[kk] * u1; } } } }
#pragma unroll
                        for (int k = 0; k < 8; ++k) { ca[k] = na[k]; cgt[k] = ng[k]; }
                    }
#undef CONF_LOAD
                    float mean[16], rstd[16];
#pragma unroll
                    for (int o = 0; o < 16; ++o) { const float s = wave_sum(a0[o] + a1[o]); if (lane == 0) red[wave * 16 + o] = s; }
                    __syncthreads();
#pragma unroll
                    for (int o = 0; o < 16; ++o) { float s = 0.f;
#pragma unroll
                        for (int w = 0; w < 8; ++w) s += red[w * 16 + o];
                        mean[o] = s * (1.0f / 1024.0f); }
                    __syncthreads();
#pragma unroll
                    for (int o = 0; o < 16; ++o) { const float e0 = a0[o] - mean[o], e1 = a1[o] - mean[o]; const float s = wave_sum(e0 * e0 + e1 * e1); if (lane == 0) red[wave * 16 + o] = s; }
                    __syncthreads();
#pragma unroll
                    for (int o = 0; o < 16; ++o) { float s = 0.f;
#pragma unroll
                        for (int w = 0; w < 8; ++w) s += red[w * 16 + o];
                        rstd[o] = 1.0f / sqrtf(s * (1.0f / 1024.0f) + LNEPS); }
                    __syncthreads();
#pragma unroll
                    for (int o = 0; o < 16; ++o) { const float y0 = (a0[o] - mean[o]) * rstd[o] * lg.x + lb.x, y1 = (a1[o] - mean[o]) * rstd[o] * lg.y + lb.y;
                        *(unsigned*)(MIXb + (size_t)(row0 + o) * D + c0) = pk2(siluf(y0), siluf(y1)); }
                }
            }
        }
        if (EN(4) && ph == 4) {
            for (int it = 0; it < 3; ++it) {
                int unit;
                if (G == 256) { if (it < 2) { const int pair = (bid & 7) * 2 + it, slot = bid >> 3; unit = (pair >> 1) * 64 + ((pair & 1) * 4 + (slot >> 3)) * 8 + (slot & 7); } else unit = bid < 64 ? 512 + bid : -1; }
                else unit = -2;
                if (unit == -1) continue;
                if (unit == -2) { if (it > 0) continue; for (int u = bid; u < 512 + 64; u += G) {
                        if (u < 512) { const int b = u >> 6, h = (u >> 3) & 7, qb = u & 7, hk = h >> 2; const size_t row0 = (size_t)b * SEQ + qb * 256;
                            attn_unit<128>(lds, Qb + row0 * 1024 + h * 128, 1024, Kb + (size_t)b * TK * 256 + hk * 128, 256, VTb + (size_t)((b * 2 + hk) * 128) * TK, TK, MIXb + row0 * D + 1024 + h * 128, D, tid);
                        } else { const int u2 = u - 512, b = u2 >> 3, h = u2 & 7, hk = h >> 2; const size_t row0 = (size_t)ML + b * CTXL;
                            attn_unit<128>(lds, Qb + row0 * 1024 + h * 128, 1024, Kb + (size_t)b * TK * 256 + hk * 128, 256, VTb + (size_t)((b * 2 + hk) * 128) * TK, CTXL, MIXb + row0 * D + 1024 + h * 128, D, tid); }
                        __syncthreads(); }
                    continue; }
                if (unit < 512) { const int b = unit >> 6, h = (unit >> 3) & 7, qb = unit & 7, hk = h >> 2; const size_t row0 = (size_t)b * SEQ + qb * 256;
                    attn_unit<128>(lds, Qb + row0 * 1024 + h * 128, 1024, Kb + (size_t)b * TK * 256 + hk * 128, 256, VTb + (size_t)((b * 2 + hk) * 128) * TK, TK, MIXb + row0 * D + 1024 + h * 128, D, tid);
                } else { const int u2 = unit - 512, b = u2 >> 3, h = u2 & 7, hk = h >> 2; const size_t row0 = (size_t)ML + b * CTXL;
                    attn_unit<128>(lds, Qb + row0 * 1024 + h * 128, 1024, Kb + (size_t)b * TK * 256 + hk * 128, 256, VTb + (size_t)((b * 2 + hk) * 128) * TK, CTXL, MIXb + row0 * D + 1024 + h * 128, D, tid); }
                __syncthreads();
            }
        }
        if (EN(5) && (ph == 5 || ph == 8 || ph == 14 || ph == 17)) {
            const int layer = ph >= 9 ? 1 : 0; const bool down = (ph == 8 || ph == 17); const int Mrows = layer ? ML : MT;
            const bf16_t* A = down ? ACTb : MIXb; const int K = down ? FF : D;
            const bf16_t* Bt = (const bf16_t*)(ws + (ph == 5 ? OFF_WEOUT : ph == 8 ? OFF_WDN0 : ph == 14 ? OFF_WOOUT : OFF_WDN1));
            pg8::Gemm g{A, Bt, Mrows, D, K}; pg8::StaticOrder S; S.init(Mrows, D, G, bid);
            const int nl = ph == 8 ? 1 : layer;
            EpiRes E{ph == 5 ? x_in : XR, ph == 5 ? ctx_in : XR + (size_t)ML * D, XR, MOD + layer * 9 * MODW, down ? 5 : 2,
                     ph == 17 ? (bf16_t*)nullptr : Hb, (ph == 8 ? args.in[6] : args.in[7]) + nl * D, MOD + nl * 9 * MODW + (ph == 8 ? 1 : 4) * D, (float*)(ws + OFF_SS) + (ph == 5 ? 0 : ph == 8 ? 1 : 2) * MT};
            pg8::gemm_phase<EpiRes, pg8::StaticOrder, true, true>(lds, g, S, E);
        }
        if (EN(7) && (ph == 7 || ph == 16)) {
            const int Mrows = ph == 16 ? ML : MT;
            pg8::Gemm g{Hb, (const bf16_t*)(ws + (ph == 7 ? OFF_WGU0 : OFF_WGU1)), Mrows, 2 * FF, D}; pg8::StaticOrder S; S.init(Mrows, 2 * FF, G, bid); EpiSwiGLU E{ACTb, (const float*)(ws + OFF_SS) + (ph == 7 ? 0 : 2) * MT, (const float*)(ws + OFF_SHW) + (ph == 7 ? SHW_F0 : SHW_F1)};
            pg8::gemm_phase<EpiSwiGLU, pg8::StaticOrder, true, true>(lds, g, S, E);
        }
        if (EN(11) && ph == 11) {
            {
                const float* sw = args.in[18]; const float* sb = args.in[19];
                LAS float* tile = (LAS float*)lds;
                u32x4 pre[3];
#define SC_LOAD(U) do { const int cb_ = (U) % 24, tb_ = ((U) / 24) & 31, b_ = (U) / (24 * 32); _Pragma("unroll") for (int p = 0; p < 3; ++p) { const int idx = tid + 512 * p, r = idx >> 4, part = idx & 15, t = tb_ * 64 - 1 + r; \
                        pre[p] = (u32x4){0u, 0u, 0u, 0u}; if (idx < 66 * 16 && t >= 0 && t < SEQ) pre[p] = *(const u32x4*)(Zb + (size_t)(b_ * SEQ + t) * INOP + cb_ * 128 + part * 8); } } while (0)
                if (bid < 8 * 32 * 24) SC_LOAD(bid);
                for (int unit = bid; unit < 8 * 32 * 24; unit += G) {
                    const int cb = unit % 24, tb = (unit / 24) & 31, b = unit / (24 * 32); const int t0 = tb * 64, ch0 = cb * 128;
#pragma unroll
                    for (int p = 0; p < 3; ++p) { const int idx = tid + 512 * p, r = idx >> 4, part = idx & 15; const u32x4 v = pre[p];
                        if (idx < 66 * 16) { LAS float* tp = tile + r * 129 + part * 8;
                            tp[0] = bflo(v.x); tp[1] = bfhi(v.x); tp[2] = bflo(v.y); tp[3] = bfhi(v.y); tp[4] = bflo(v.z); tp[5] = bfhi(v.z); tp[6] = bflo(v.w); tp[7] = bfhi(v.w); } }
                    __syncthreads();
                    if (unit + G < 8 * 32 * 24) SC_LOAD(unit + G);
                    const int cl = ch0 + wave * 16 + (lane & 15); const float w0v = sw[cl], w1v = sw[3072 + cl], w2v = sw[6144 + cl], bv = sb[cl];
#pragma unroll
                    for (int q = 0; q < 16; ++q) { const int ch = wave * 16 + q, cglob = ch0 + ch;
                        const float w0 = __builtin_bit_cast(float, __builtin_amdgcn_readlane(__builtin_bit_cast(int, w0v), q)), w1 = __builtin_bit_cast(float, __builtin_amdgcn_readlane(__builtin_bit_cast(int, w1v), q));
                        const float w2 = __builtin_bit_cast(float, __builtin_amdgcn_readlane(__builtin_bit_cast(int, w2v), q)), bq = __builtin_bit_cast(float, __builtin_amdgcn_readlane(__builtin_bit_cast(int, bv), q));
                        const float v = w0 * tile[lane * 129 + ch] + w1 * tile[(lane + 1) * 129 + ch] + w2 * tile[(lane + 2) * 129 + ch] + bq;
                        HXb[((size_t)cglob * 8 + b) * SEQ + t0 + lane] = (bf16_t)f2bf(v); }
                    __syncthreads();
                }
#undef SC_LOAD
            }
            {
                const float* w4 = args.in[26]; const float* skip = args.in[28];
                LAS float* red = (LAS float*)lds;
                constexpr float DMIN = -3.0701134573253945f, DMAX = -15.350567286626972f;
                for (int unit = bid; unit < 256; unit += G) {
                    const int col = tid & 15, tg = tid >> 4, j = unit * 16 + col; const int dir = j >> 11, n = (j >> 10) & 1, c = j & 1023;
                    float w4r[64];
#pragma unroll
                    for (int m = 0; m < 64; ++m) w4r[m] = w4[m * 4096 + j];
                    const float delta = fabsf(DMIN + (float)c * ((DMAX - DMIN) / 1023.0f));
                    float asum = 0.f;
                    float* fp = FILT + (size_t)(n * 1024 + c) * 4096;
                    LAS float* hst = (LAS float*)(lds + 4096);
                    f32x4 hpre[8];
#pragma unroll
                    for (int p = 0; p < 8; ++p) hpre[p] = *(const f32x4*)(H3 + (tid + 512 * p) * 4);
                    const float r32 = expf(-(32.0f / (float)(SEQ - 1)) * delta);
                    for (int chk = 0; chk < 8; ++chk) {
                        __syncthreads();
#pragma unroll
                        for (int p = 0; p < 8; ++p) *(LAS f32x4*)(hst + (tid + 512 * p) * 4) = hpre[p];
                        __syncthreads();
                        if (chk < 7) {
#pragma unroll
                            for (int p = 0; p < 8; ++p) hpre[p] = *(const f32x4*)(H3 + (chk + 1) * 256 * 64 + (tid + 512 * p) * 4); }
                        float dec = expf(-((float)(chk * 256 + tg) / (float)(SEQ - 1)) * delta);
#pragma unroll 2
                        for (int i = 0; i < 8; ++i) { const int tl = tg + 32 * i, t = chk * 256 + tl; const LAS f32x4* hp = (const LAS f32x4*)(hst + tl * 64); float dot = 0.f;
#pragma unroll
                            for (int m4 = 0; m4 < 16; ++m4) { const f32x4 hv = hp[m4]; dot += hv.x * w4r[4 * m4] + hv.y * w4r[4 * m4 + 1] + hv.z * w4r[4 * m4 + 2] + hv.w * w4r[4 * m4 + 3]; }
                            const float v = dot * dec; dec *= r32; asum += fabsf(v);
                            if (dir == 0) fp[2048 + t] = v; else if (t >= 1) fp[2048 - t] = v; }
                    }
                    __syncthreads();
                    red[tg * 16 + col] = asum;
                    __syncthreads();
                    float tot = 0.f;
                    for (int q = 0; q < 32; ++q) tot += red[q * 16 + col];
                    const float nrm = 1.0f / (tot + 1e-6f);
#pragma unroll 1
                    for (int i0 = 0; i0 < 64; i0 += 16) { float vv[16];
#pragma unroll
                        for (int i = 0; i < 16; ++i) { const int t = tg + 32 * (i0 + i); const int idx = dir == 0 ? 2048 + t : (t >= 1 ? 2048 - t : 2048); vv[i] = fp[idx]; }
#pragma unroll
                        for (int i = 0; i < 16; ++i) { const int t = tg + 32 * (i0 + i); float v = vv[i] * nrm;
                            if (dir == 0) { if (t == 0) v += skip[n * 1024 + c]; fp[2048 + t] = v; }
                            else { if (t >= 1) fp[2048 - t] = v; else fp[0] = 0.f; } } }
                }
            }
            {
                const float* qng = args.in[29]; const float* kvg = args.in[30];
                const int jr = lane & 15, sub = (lane >> 4) & 1, e0 = sub * 32 + jr, e1 = e0 + 16;
                const float inv = exp2f(-(float)jr * (LOG2_THETA / 16.0f));
                for (int row = gw; row < MT; row += NGW) {
                    const bool lat = row < ML; const int b = lat ? (row >> 11) : ((row - ML) >> 8); const int t = lat ? (row & 2047) : ((row - ML) & 255);
                    const int Tpos = lat ? CTXL + t : t;
                    const bf16_t* zkv = lat ? Zb + (size_t)row * INOP + 3584 : ZCb + (size_t)(row - ML) * 512;
                    if (lat) { const u32x4 v = *(const u32x4*)(Zb + (size_t)row * INOP + 3072 + lane * 8);
                        float f[8] = {bflo(v.x), bfhi(v.x), bflo(v.y), bfhi(v.y), bflo(v.z), bfhi(v.z), bflo(v.w), bfhi(v.w)}; float ss = 0.f;
#pragma unroll
                        for (int k = 0; k < 8; ++k) ss += f[k] * f[k];
                        const float rs = 1.0f / sqrtf(wave_sum(ss) * (1.0f / 512.0f) + NEPS);
                        const f32x4 g0 = *(const f32x4*)(qng + lane * 8), g1 = *(const f32x4*)(qng + lane * 8 + 4);
                        u32x4 w; w.x = pk2(f[0] * rs * g0.x, f[1] * rs * g0.y); w.y = pk2(f[2] * rs * g0.z, f[3] * rs * g0.w); w.z = pk2(f[4] * rs * g1.x, f[5] * rs * g1.y); w.w = pk2(f[6] * rs * g1.z, f[7] * rs * g1.w);
                        *(u32x4*)(QNb + (size_t)row * 512 + lane * 8) = w; }
                    { const u32x2 v = *(const u32x2*)(zkv + lane * 4); const float f0 = bflo(v.x), f1 = bfhi(v.x), f2 = bflo(v.y), f3 = bfhi(v.y);
                        const float rs = 1.0f / sqrtf(wave_sum(f0 * f0 + f1 * f1 + f2 * f2 + f3 * f3) * (1.0f / 256.0f) + NEPS);
                        const f32x4 g = *(const f32x4*)(kvg + lane * 4);
                        u32x2 w; w.x = pk2(f0 * rs * g.x, f1 * rs * g.y); w.y = pk2(f2 * rs * g.z, f3 * rs * g.w);
                        *(u32x2*)(CKVb + (size_t)row * 256 + lane * 4) = w; }
                    if (lane < 32) { float x0 = bf2f(zkv[256 + e0]), x1 = bf2f(zkv[256 + e1]);
                        if (lat) { const float pos = sub ? (float)(t & 63) : (float)(t >> 6); float sn, cs; { const float ang = pos * inv; sn = sinf(ang); cs = cosf(ang); } const float y0 = x0 * cs - x1 * sn, y1 = x0 * sn + x1 * cs; x0 = y0; x1 = y1; }
                        const bf16_t r0 = (bf16_t)f2bf(x0), r1 = (bf16_t)f2bf(x1); bf16_t* kp = Kb + (size_t)(b * TK + Tpos) * 1536 + 128;
#pragma unroll
                        for (int h = 0; h < 8; ++h) { kp[h * 192 + e0] = r0; kp[h * 192 + e1] = r1; } }
                }
            }
        }
        if (EN(12) && ph == 12) {
            if (SUB(2)) {
                constexpr int FL = 4240, UL = 2704;
                LAS unsigned char* Fc = lds;
                LAS unsigned char* Ul = lds + 8 * FL * 2;
                const int i16 = lane & 15, kg = lane >> 4, sg = i16 >> 3, bb = i16 & 7;
                const int pq = (wave & 1) + 32 * (wave >> 1);
                const int abase = ((i16 & 7) * FL + 8 * kg - (i16 & 8) + 2048 - 16 * pq) * 2;
                const int bbase = (bb * UL + 264 * sg) * 2;
                { const int b = tid >> 6, ch = tid & 63, pos = ch < 32 ? 8 * ch : 2376 + 8 * (ch - 32);
                  *(LAS u32x4*)(Ul + (b * UL + pos) * 2) = (u32x4){0u, 0u, 0u, 0u}; }
                for (int c = bid; c < 1024; c += G) {
                    { const bf16_t* vp = HXb + ((size_t)(2 * 1024 + c) * 8) * SEQ;
#pragma unroll
                      for (int p = 0; p < 4; ++p) { const int idx = tid + 512 * p, b = idx >> 8, part = idx & 255; const int sp = 256 + 8 * part;
                          *(LAS u32x4*)(Ul + (b * UL + sp + 8 * (sp >> 8)) * 2) = *(const u32x4*)(vp + (size_t)b * SEQ + part * 8); } }
#pragma unroll 1
                    for (int n = 0; n < 2; ++n) {
                        { const float* fp = FILT + (size_t)(n * 1024 + c) * 4096 + 2048;
#pragma unroll
                          for (int k = 0; k < 9; ++k) { const int g0 = tid + 512 * k, g = g0 < 8 * (FL / 8) ? g0 : 0; const int m = g & 7, Y0 = 8 * (g >> 3); const int d0 = 2048 + m - Y0;
                              float v[8];
#pragma unroll
                              for (int j = 0; j < 8; ++j) { const int d = d0 - j, dc = d < -2047 ? -2047 : (d > 2047 ? 2047 : d); const float x = fp[dc]; v[j] = (d == dc) ? x : 0.f; }
                              u32x4 w; w.x = cvtpk(v[0], v[1]); w.y = cvtpk(v[2], v[3]); w.z = cvtpk(v[4], v[5]); w.w = cvtpk(v[6], v[7]);
                              if (g0 < 8 * (FL / 8)) *(LAS u32x4*)(Fc + (m * FL + Y0) * 2) = w; } }
                        const bf16_t* gp = HXb + ((size_t)(n * 1024 + c) * 8 + bb) * SEQ;
                        u32x2 gv[8];
#pragma unroll
                        for (int r = 0; r < 8; ++r) gv[r] = *(const u32x2*)(gp + 16 * ((wave & 1) + 2 * (16 * (wave >> 1) + 8 * sg + r)) + 4 * kg);
                        __syncthreads();
                        pg8::f32x4 acc[8];
#pragma unroll
                        for (int r = 0; r < 8; ++r) acc[r] = (pg8::f32x4){0.f, 0.f, 0.f, 0.f};
                        bf16x8 aw[9];
#pragma unroll
                        for (int r = 0; r < 8; ++r) aw[(r + 8) % 9] = *(const LAS bf16x8*)(Fc + abase + 64 * (-8 - r));
                        bf16x8 bcur = *(const LAS bf16x8*)(Ul + bbase + (8 * kg) * 2);
#pragma unroll 1
                        for (int it = 0; it < 8; ++it) {
#pragma unroll
                            for (int u = 0; u < 9; ++u) {
                                const int J = -8 + 9 * it + u;
                                aw[(16 - u) % 9] = *(const LAS bf16x8*)(Fc + abase + 64 * (J + 1));
                                const int sbn = 288 * it + 32 * (u + 1) + 8 * kg;
                                const bf16x8 bnext = *(const LAS bf16x8*)(Ul + bbase + (sbn + 8 * (sbn >> 8)) * 2);
#pragma unroll
                                for (int r = 0; r < 8; ++r) acc[r] = __builtin_amdgcn_mfma_f32_16x16x32_bf16(aw[(r + 8 - u) % 9], bcur, acc[r], 0, 0, 0);
                                bcur = bnext;
                            }
                        }
                        __syncthreads();
#pragma unroll
                        for (int r = 0; r < 8; ++r) { const int t0 = 16 * ((wave & 1) + 2 * (16 * (wave >> 1) + 8 * sg + r)) + 4 * kg;
                            u32x2 w; w.x = cvtpk(bflo(gv[r].x) * acc[r][0], bfhi(gv[r].x) * acc[r][1]); w.y = cvtpk(bflo(gv[r].y) * acc[r][2], bfhi(gv[r].y) * acc[r][3]);
                            if (n == 0) { const int sp = 256 + t0; *(LAS u32x2*)(Ul + (bb * UL + sp + 8 * (sp >> 8)) * 2) = w; }
                            else *(u32x2*)(Zb + ((size_t)c * 8 + bb) * SEQ + t0) = w; }
                    }
                }
                __syncthreads();
            }
            const int kop = args.ph_hi > 1000 ? 128 : 256;
            if (SUB(3)) { pg8::Gemm g{QNb, (const bf16_t*)(ws + OFF_WUQ), ML, 1536, 2 * kop}; pg8::StaticOrder S; S.init(ML, 1536, G, bid); EpiRopeQ E{Qb, 0.07216878364870323f * LOG2E, (const float*)(ws + OFF_ROPE16)};
              pg8::gemm_phase<EpiRopeQ, pg8::StaticOrder, true, true>(lds, g, S, E); }
            if (SUB(4)) { pg8::Gemm g{CKVb, (const bf16_t*)(ws + OFF_WUKV), MT, 1024, kop}; pg8::StaticOrder S; S.init(MT, 1024, G, bid); EpiKnope E{Kb};
              pg8::gemm_phase<EpiKnope, pg8::StaticOrder, true, true>(lds, g, S, E); }
            if (SUB(5)) { pg8::Gemm g{(const bf16_t*)(ws + OFF_WUKV) + (size_t)1024 * 256, CKVb, 1024, MT, kop}; pg8::StaticOrder S; S.init(1024, MT, G, bid); EpiVt E{VTb};
              pg8::gemm_phase<EpiVt, pg8::StaticOrder, true, true>(lds, g, S, E); }
        }
        if (EN(13) && ph == 13) {
            for (int u0 = bid; u0 < 512; u0 += G) {
                int unit = u0;
                if (G == 256) { const int it = u0 >> 8, slot = bid >> 3; unit = (((bid & 7) * 2 + it) * 4 + (slot >> 3)) * 8 + (slot & 7); }
                const int b = unit >> 6, h = (unit >> 3) & 7, qb = unit & 7; const size_t row0 = (size_t)b * SEQ + qb * 256;
                attn_unit_simple<192>(lds, Qb + row0 * 1536 + h * 192, 1536, Kb + (size_t)b * TK * 1536 + h * 192, 1536, VTb + (size_t)((b * 8 + h) * 128) * TK, TK, MIXb + row0 * D + 1024 + h * 128, D, tid);
                __syncthreads();
            }
            {
                LAS bf16_t* tile = (LAS bf16_t*)lds;
                const bf16_t* yp = Zb;
                for (int unit = bid; unit < 8 * 32 * 8; unit += G) {
                    const int cb = unit & 7, tb = (unit >> 3) & 31, b = unit >> 8; const int t0 = tb * 64, c0 = cb * 128;
#pragma unroll
                    for (int p = 0; p < 2; ++p) { const int idx = tid + 512 * p, cc = idx >> 3, part = idx & 7; const u32x4 v = *(const u32x4*)(yp + ((size_t)(c0 + cc) * 8 + b) * SEQ + t0 + part * 8);
                        LAS unsigned* tp = (LAS unsigned*)(tile + cc * 66 + part * 8); tp[0] = v.x; tp[1] = v.y; tp[2] = v.z; tp[3] = v.w; }
                    __syncthreads();
#pragma unroll
                    for (int p = 0; p < 2; ++p) { const int idx = tid + 512 * p, t = idx >> 4, part = idx & 15; const LAS bf16_t* sp = tile + (part * 8) * 66 + t;
                        u32x4 w; w.x = (unsigned)sp[0] | ((unsigned)sp[66] << 16); w.y = (unsigned)sp[2 * 66] | ((unsigned)sp[3 * 66] << 16); w.z = (unsigned)sp[4 * 66] | ((unsigned)sp[5 * 66] << 16); w.w = (unsigned)sp[6 * 66] | ((unsigned)sp[7 * 66] << 16);
                        *(u32x4*)(MIXb + (size_t)(b * SEQ + t0 + t) * D + c0 + part * 8) = w; }
                    __syncthreads();
                }
            }
        }
        if (EN(18) && ph == 18) {
            const float* g = args.in[36];
            f32x4 v[8], nv[8];
            if (gw < ML) {
#pragma unroll
                for (int j = 0; j < 8; ++j) v[j] = ((const f32x4*)(XR + (size_t)gw * D))[lane + 64 * j]; }
            for (int row = gw; row < ML; row += NGW) {
                const int nrow = row + NGW;
                if (nrow < ML) {
#pragma unroll
                    for (int j = 0; j < 8; ++j) nv[j] = ((const f32x4*)(XR + (size_t)nrow * D))[lane + 64 * j]; }
                float ss = 0.f;
#pragma unroll
                for (int j = 0; j < 8; ++j) ss += (v[j].x * v[j].x + v[j].y * v[j].y) + (v[j].z * v[j].z + v[j].w * v[j].w);
                const float rs = 1.0f / sqrtf(wave_sum(ss) * (1.0f / D) + NEPS);
                f32x4* op = (f32x4*)(args.out + (size_t)row * D);
#pragma unroll
                for (int j = 0; j < 8; ++j) { const f32x4 gg = ((const f32x4*)g)[lane + 64 * j]; op[lane + 64 * j] = v[j] * rs * gg; }
#pragma unroll
                for (int j = 0; j < 8; ++j) v[j] = nv[j];
            }
        }
}

#ifndef DUPMASK
#define DUPMASK 0u
#endif
#ifndef SYNCDUP
#define SYNCDUP 0
#endif
#define GRID_BAR(k) do { if ((k) == 0) grid.sync(); else xcd_barrier(bar); } while (0)
#define RUN_PHASE(k) do { if ((k) != 6 && (k) != 9 && (k) != 15 && args.ph_lo <= (k) && (k) < args.ph_hi) { run_phase<(k)>(args, lds); \
    if (((DUPMASK) >> (k)) & 1u) { GRID_BAR(k); run_phase<(k)>(args, lds); } \
    if ((k) + 1 < args.ph_hi) { GRID_BAR(k); if (SYNCDUP) GRID_BAR(k); } } } while (0)
__global__ void __launch_bounds__(512, 2) mega_fwd(Args args) {
    extern __shared__ __attribute__((aligned(16))) unsigned char lds_raw[];
    LAS unsigned char* lds = (LAS unsigned char*)lds_raw;
    cg::grid_group grid = cg::this_grid();
    volatile LAS unsigned* bst = (volatile LAS unsigned*)(lds + LDS_BYTES - 64);
    if (threadIdx.x < 2) bst[threadIdx.x] = 0u;
    __syncthreads();
    const XcdBarrier bar = xcd_barrier_post((unsigned*)args.ws, bst);
    RUN_PHASE(0); RUN_PHASE(1); RUN_PHASE(2); RUN_PHASE(3); RUN_PHASE(4); RUN_PHASE(5); RUN_PHASE(6); RUN_PHASE(7); RUN_PHASE(8); RUN_PHASE(9);
    RUN_PHASE(10); RUN_PHASE(11); RUN_PHASE(12); RUN_PHASE(13); RUN_PHASE(14); RUN_PHASE(15); RUN_PHASE(16); RUN_PHASE(17); RUN_PHASE(18);
}
}

extern "C" void kernel_launch(void* const* d_in, const int* in_sizes, int n_in, void* d_out, int out_size, void* d_ws, size_t ws_size, hipStream_t stream) {
    static int grid = 0;
    if (grid == 0) {
        if (n_in != 37 || ws_size < mk::WS_END) { fprintf(stderr, "kernel_launch: unexpected n_in %d / ws_size %zu\n", n_in, ws_size); grid = -1; return; }
        int dev = 0, cus = 0, per_cu = 0;
        hipGetDevice(&dev); hipDeviceGetAttribute(&cus, hipDeviceAttributeMultiprocessorCount, dev);
        hipFuncSetAttribute((const void*)mk::mega_fwd, hipFuncAttributeMaxDynamicSharedMemorySize, mk::LDS_BYTES);
        hipOccupancyMaxActiveBlocksPerMultiprocessor(&per_cu, (const void*)mk::mega_fwd, 512, mk::LDS_BYTES);
        if (per_cu < 1) { fprintf(stderr, "kernel_launch: occupancy query says %d\n", per_cu); per_cu = 1; }
        (void)hipGetLastError();
        grid = cus * 1;
    }
    if (grid < 0) return;
    if (hipMemsetAsync(d_ws, 0, 16384, stream) != hipSuccess) { fprintf(stderr, "kernel_launch: memset failed\n"); return; }
    mk::Args a{};
    for (int i = 0; i < 37; ++i) a.in[i] = (const float*)d_in[i];
    a.out = (float*)d_out; a.ws = (unsigned char*)d_ws; a.ph_lo = 0; a.ph_hi = mk::NPHASE;
    void* kargs[] = {&a};
    hipError_t e = hipLaunchCooperativeKernel((const void*)mk::mega_fwd, dim3(grid), dim3(512), kargs, mk::LDS_BYTES, stream);
    if (e != hipSuccess) fprintf(stderr, "cooperative launch failed: %s (grid %d)\n", hipGetErrorString(e), grid);
}
```
